# Optimizing an MI355X kernel written in HIP

```python
import jax, jax.numpy as jnp
from jax import lax
import numpy as np

D_MODEL = 1024
BATCH = 8
SEQ = 2048
DEPTH = 4
DEC_BATCH = 128
DEC_SEQ = 1
PAST_LEN = 8192
PAGE_SIZE = 128

N_A_LAYERS = DEPTH // 2
N_B_LAYERS = DEPTH - N_A_LAYERS
CHUNK = 128
SGU_WIDTH = 2 * D_MODEL
SGU_GROUPS = 8
SGU_GROUP_DIM = SGU_WIDTH // SGU_GROUPS
N_HEADS = 8
QK_NOPE = 128
QK_ROPE = 64
V_HEAD = 128
Q_LORA = D_MODEL // 2
KV_LORA = D_MODEL // 4
ROPE_THETA = 10000.0
Q_BLOCK = 128
ATTN_SCALE = (QK_NOPE + QK_ROPE) ** -0.5
D_FF = 11 * D_MODEL // 4
CONV_W = 3
EPS = 1e-6

kernel_name = "yoco_sgu_mla_convffn_step"


def rms_norm(x, g):
    xf = x.astype(jnp.float32)
    y = xf * lax.rsqrt(jnp.mean(xf * xf, axis=-1, keepdims=True) + EPS)
    return (y * g.astype(jnp.float32)).astype(x.dtype)


def rope(x, pos):
    half = QK_ROPE // 2
    inv = 1.0 / (ROPE_THETA ** (jnp.arange(half, dtype=jnp.float32) / half))
    ang = pos.astype(jnp.float32)[:, None] * inv[None, :]
    shp = (ang.shape[0],) + (1,) * (x.ndim - 3) + (half,)
    cos, sin = jnp.cos(ang).reshape(shp), jnp.sin(ang).reshape(shp)
    xf = x.astype(jnp.float32)
    x1, x2 = xf[..., :half], xf[..., half:]
    return jnp.concatenate([x1 * cos - x2 * sin, x2 * cos + x1 * sin], axis=-1).astype(x.dtype)


def sgu_mixer(h, w_in, sgu_g, w_s, b_s, w_out):
    n, t, _ = h.shape
    z = jax.nn.gelu(h @ w_in, approximate=False)
    u, v = jnp.split(z, 2, axis=-1)
    v = rms_norm(v, sgu_g)
    cl = CHUNK if t >= CHUNK else t
    pad = (-t) % cl
    n_chunks = (t + pad) // cl
    vp = jnp.pad(v, ((0, 0), (0, pad), (0, 0))).reshape(n, n_chunks, cl, SGU_GROUPS, SGU_GROUP_DIM)
    causal = jnp.tril(jnp.ones((cl, cl), dtype=bool))
    wm = jnp.where(causal[None], w_s[:, :cl, :cl], 0)
    s = jnp.einsum('gts,ncsgd->nctgd', wm, vp) + b_s[:, :cl].T[:, :, None]
    s = s.reshape(n, n_chunks * cl, SGU_WIDTH)[:, :t]
    return (u * s) @ w_out, v


def conv_ffn(h, conv_prev, w_up, conv_w, conv_b, w_down):
    t = h.shape[1]
    a = h @ w_up
    ap = jnp.concatenate([conv_prev.astype(a.dtype), a], axis=1)
    c = conv_b + ap[:, 0:t] * conv_w[0]
    for k in range(1, CONV_W):
        c = c + ap[:, k:k + t] * conv_w[k]
    g, u = jnp.split(c, 2, axis=-1)
    return (jax.nn.gelu(g, approximate=True) * u) @ w_down, ap[:, t:]


def kv_side(h, pos, kv_in_g, w_dkv, kv_g):
    kv = rms_norm(h, kv_in_g) @ w_dkv
    return rms_norm(kv[..., :KV_LORA], kv_g), rope(kv[..., KV_LORA:], pos)


def mla_attend(q_lat, q_pe, q_pos, ckv, kr, k_pos):
    n, t = q_lat.shape[:2]
    qb = Q_BLOCK if t % Q_BLOCK == 0 else t
    nb = t // qb

    def block(args):
        ql, qp, pq = args
        s = (jnp.einsum('nthc,nsc->nhts', ql, ckv, preferred_element_type=jnp.float32)
             + jnp.einsum('nthr,nsr->nhts', qp, kr, preferred_element_type=jnp.float32)) * ATTN_SCALE
        s = jnp.where(k_pos[None, None, None, :] <= pq[None, None, :, None], s, -jnp.inf)
        p = jax.nn.softmax(s, axis=-1).astype(ckv.dtype)
        return jnp.einsum('nhts,nsc->nthc', p, ckv)

    qlb = q_lat.reshape(n, nb, qb, N_HEADS, KV_LORA).transpose(1, 0, 2, 3, 4)
    qpb = q_pe.reshape(n, nb, qb, N_HEADS, QK_ROPE).transpose(1, 0, 2, 3, 4)
    out = lax.map(block, (qlb, qpb, q_pos.reshape(nb, qb)))
    return out.transpose(1, 0, 2, 3, 4).reshape(n, t, N_HEADS, KV_LORA)


def mla_mixer(h, pos, ckv, kr, k_pos, w_dq, q_g, w_uq, w_uk, w_uv, w_o):
    n, t, _ = h.shape
    cq = rms_norm(h @ w_dq, q_g)
    q = (cq @ w_uq).reshape(n, t, N_HEADS, QK_NOPE + QK_ROPE)
    q_pe = rope(q[..., QK_NOPE:], pos)
    q_lat = jnp.einsum('nthd,chd->nthc', q[..., :QK_NOPE], w_uk)
    o_lat = mla_attend(q_lat, q_pe, pos, ckv, kr, k_pos)
    o = jnp.einsum('nthc,chd->nthd', o_lat, w_uv).reshape(n, t, N_HEADS * V_HEAD)
    return o @ w_o


def run_group(x, pos, past_ckv, past_kr, conv_prev, p):
    v_rows, conv_new = [], []
    ckv_new = kr_new = ckv_all = kr_all = k_pos = None
    for layer in range(DEPTH):
        if layer == N_A_LAYERS:
            ckv_new, kr_new = kv_side(x, pos, p['kv_in_g'], p['w_dkv'], p['kv_g'])
            if past_ckv is None:
                ckv_all, kr_all, k_pos = ckv_new, kr_new, pos
            else:
                past_len = past_ckv.shape[1]
                ckv_all = jnp.concatenate([past_ckv.astype(ckv_new.dtype), ckv_new], axis=1)
                kr_all = jnp.concatenate([past_kr.astype(kr_new.dtype), kr_new], axis=1)
                k_pos = jnp.concatenate([jnp.arange(past_len, dtype=jnp.int32), pos])
        h = rms_norm(x, p['pre_mix_g'][layer])
        if layer < N_A_LAYERS:
            m, v = sgu_mixer(h, p['w_in_a'][layer], p['sgu_g'][layer], p['w_s'][layer],
                             p['b_s'][layer], p['w_out_a'][layer])
            v_rows.append(v)
        else:
            j = layer - N_A_LAYERS
            m = mla_mixer(h, pos, ckv_all, kr_all, k_pos, p['w_dq'][j], p['q_g'][j], p['w_uq'][j],
                          p['w_uk'], p['w_uv'], p['w_o'][j])
        x = x + rms_norm(m, p['post_mix_g'][layer])
        h = rms_norm(x, p['pre_ffn_g'][layer])
        f, cs = conv_ffn(h, conv_prev[layer], p['w_up'][layer], p['conv_w'][layer],
                         p['conv_b'][layer], p['w_down'][layer])
        conv_new.append(cs)
        x = x + rms_norm(f, p['post_ffn_g'][layer])
    return x, ckv_new, kr_new, jnp.stack(conv_new), jnp.stack(v_rows)


def setup_inputs(seed: int = 0) -> dict:
    key = jax.random.key(seed)
    ks = iter(jax.random.split(key, 40))
    f32 = jnp.float32

    def nrm(shape, scale):
        return jax.random.normal(next(ks), shape, f32) * scale

    def gain(shape):
        return 1.0 + 0.1 * jax.random.normal(next(ks), shape, f32)

    n_pages = PAST_LEN // PAGE_SIZE
    n_used = DEC_BATCH * n_pages
    n_pool = n_used + max(1, n_used // 4)
    page_table = jax.random.permutation(next(ks), n_pool)[:n_used].reshape(DEC_BATCH, n_pages).astype(jnp.int32)
    return {
        'x_prompt': nrm((BATCH, SEQ, D_MODEL), 1.0),
        'x_sample': nrm((DEC_BATCH, DEC_SEQ, D_MODEL), 1.0),
        'cache_ckv': nrm((n_pool, PAGE_SIZE, KV_LORA), 1.0),
        'cache_kr': nrm((n_pool, PAGE_SIZE, QK_ROPE), 1.0),
        'state_conv': nrm((DEPTH, DEC_BATCH, CONV_W - 1, 2 * D_FF), 1.0),
        'page_table': page_table,
        'pre_mix_g': gain((DEPTH, D_MODEL)),
        'post_mix_g': gain((DEPTH, D_MODEL)),
        'pre_ffn_g': gain((DEPTH, D_MODEL)),
        'post_ffn_g': gain((DEPTH, D_MODEL)),
        'w_in_a': nrm((N_A_LAYERS, D_MODEL, 2 * SGU_WIDTH), D_MODEL ** -0.5),
        'sgu_g': gain((N_A_LAYERS, SGU_WIDTH)),
        'w_s': nrm((N_A_LAYERS, SGU_GROUPS, CHUNK, CHUNK), CHUNK ** -0.5),
        'b_s': gain((N_A_LAYERS, SGU_GROUPS, CHUNK)),
        'w_out_a': nrm((N_A_LAYERS, SGU_WIDTH, D_MODEL), SGU_WIDTH ** -0.5),
        'kv_in_g': gain((D_MODEL,)),
        'w_dkv': nrm((D_MODEL, KV_LORA + QK_ROPE), D_MODEL ** -0.5),
        'kv_g': gain((KV_LORA,)),
        'w_uk': nrm((KV_LORA, N_HEADS, QK_NOPE), KV_LORA ** -0.5),
        'w_uv': nrm((KV_LORA, N_HEADS, V_HEAD), KV_LORA ** -0.5),
        'w_dq': nrm((N_B_LAYERS, D_MODEL, Q_LORA), D_MODEL ** -0.5),
        'q_g': gain((N_B_LAYERS, Q_LORA)),
        'w_uq': nrm((N_B_LAYERS, Q_LORA, N_HEADS * (QK_NOPE + QK_ROPE)), Q_LORA ** -0.5),
        'w_o': nrm((N_B_LAYERS, N_HEADS * V_HEAD, D_MODEL), (N_HEADS * V_HEAD) ** -0.5),
        'w_up': nrm((DEPTH, D_MODEL, 2 * D_FF), D_MODEL ** -0.5),
        'conv_w': nrm((DEPTH, CONV_W, 2 * D_FF), CONV_W ** -0.5),
        'conv_b': nrm((DEPTH, 2 * D_FF), 0.01),
        'w_down': nrm((DEPTH, D_FF, D_MODEL), D_FF ** -0.5),
    }


def reference(x_prompt, x_sample, cache_ckv, cache_kr, state_conv, page_table,
              pre_mix_g, post_mix_g, pre_ffn_g, post_ffn_g,
              w_in_a, sgu_g, w_s, b_s, w_out_a,
              kv_in_g, w_dkv, kv_g, w_uk, w_uv,
              w_dq, q_g, w_uq, w_o,
              w_up, conv_w, conv_b, w_down):
    p = dict(pre_mix_g=pre_mix_g, post_mix_g=post_mix_g, pre_ffn_g=pre_ffn_g, post_ffn_g=post_ffn_g,
             w_in_a=w_in_a, sgu_g=sgu_g, w_s=w_s, b_s=b_s, w_out_a=w_out_a,
             kv_in_g=kv_in_g, w_dkv=w_dkv, kv_g=kv_g, w_uk=w_uk, w_uv=w_uv,
             w_dq=w_dq, q_g=q_g, w_uq=w_uq, w_o=w_o,
             w_up=w_up, conv_w=conv_w, conv_b=conv_b, w_down=w_down)

    bp, tp, _ = x_prompt.shape
    pos_p = jnp.arange(tp, dtype=jnp.int32)
    conv0 = jnp.zeros((DEPTH, bp, CONV_W - 1, 2 * D_FF), x_prompt.dtype)
    y_prompt, new_ckv_prompt, new_kr_prompt, new_conv_prompt, _ = run_group(
        x_prompt, pos_p, None, None, conv0, p)

    nb, n_pages = page_table.shape
    past_len = n_pages * PAGE_SIZE
    past_ckv = cache_ckv[page_table].reshape(nb, past_len, KV_LORA)
    past_kr = cache_kr[page_table].reshape(nb, past_len, QK_ROPE)
    pos_s = past_len + jnp.arange(x_sample.shape[1], dtype=jnp.int32)
    y_sample, new_ckv_sample, new_kr_sample, new_conv_sample, new_chunkv_sample = run_group(
        x_sample, pos_s, past_ckv, past_kr, state_conv, p)

    return (y_prompt, y_sample, new_ckv_prompt, new_kr_prompt, new_conv_prompt,
            new_ckv_sample, new_kr_sample, new_conv_sample, new_chunkv_sample)
```

```cpp
#include <hip/hip_runtime.h>
#include <cstdio>
#include <cstdint>

constexpr int D_MODEL = 1024, BATCH = 8, SEQ = 2048, DEPTH = 4, DEC_BATCH = 128, PAST_LEN = 8192, PAGE = 128;
constexpr int N_A = 2, CHUNK = 128, SGU_W = 2048, SGU_G = 8, SGU_GD = 256;
constexpr int NH = 8, QK_NOPE = 128, QK_ROPE = 64, V_HEAD = 128, Q_LORA = 512, KV_LORA = 256;
constexpr int D_FF = 2816, FF2 = 5632;
constexpr float EPS = 1e-6f;
constexpr int MP = BATCH * SEQ;
constexpr int MS = DEC_BATCH;
constexpr int NPAGES = PAST_LEN / PAGE;

__device__ __forceinline__ float block_sum_256(float v, float* red) {
    for (int o = 32; o >= 1; o >>= 1) v += __shfl_xor(v, o);
    const int w = threadIdx.x >> 6;
    __syncthreads();
    if ((threadIdx.x & 63) == 0) red[w] = v;
    __syncthreads();
    float s = red[0] + red[1] + red[2] + red[3];
    return s;
}
__device__ __forceinline__ float block_max_256(float v, float* red) {
    for (int o = 32; o >= 1; o >>= 1) v = fmaxf(v, __shfl_xor(v, o));
    const int w = threadIdx.x >> 6;
    __syncthreads();
    if ((threadIdx.x & 63) == 0) red[w] = v;
    __syncthreads();
    return fmaxf(fmaxf(red[0], red[1]), fmaxf(red[2], red[3]));
}

__global__ void __launch_bounds__(256) nk_rmsnorm(const float* in, int ldi, const float* g, float* out, int ldo, int D) {
    __shared__ float red[4];
    const float* r = in + (size_t)blockIdx.x * ldi; float* o = out + (size_t)blockIdx.x * ldo;
    float s = 0.f;
    for (int i = threadIdx.x; i < D; i += 256) { const float v = r[i]; s += v * v; }
    s = block_sum_256(s, red);
    const float rstd = rsqrtf(s / (float)D + EPS);
    for (int i = threadIdx.x; i < D; i += 256) o[i] = r[i] * rstd * g[i];
}
__global__ void __launch_bounds__(256) nk_resid_rmsnorm(float* x, const float* m, const float* g, int D) {
    __shared__ float red[4];
    const float* r = m + (size_t)blockIdx.x * D; float* o = x + (size_t)blockIdx.x * D;
    float s = 0.f;
    for (int i = threadIdx.x; i < D; i += 256) { const float v = r[i]; s += v * v; }
    s = block_sum_256(s, red);
    const float rstd = rsqrtf(s / (float)D + EPS);
    for (int i = threadIdx.x; i < D; i += 256) o[i] += r[i] * rstd * g[i];
}

template <bool TB>
__global__ void __launch_bounds__(256) nk_gemm(const float* __restrict__ A, int lda, const float* __restrict__ B, int ldb, float* C, int ldc, int M, int N, int K, int accum) {
    __shared__ float As[16][65];
    __shared__ float Bs[16][65];
    const int tx = threadIdx.x & 15, ty = threadIdx.x >> 4;
    const int m0 = blockIdx.y * 64, n0 = blockIdx.x * 64;
    float acc[4][4];
#pragma unroll
    for (int i = 0; i < 4; ++i)
#pragma unroll
        for (int j = 0; j < 4; ++j) acc[i][j] = 0.f;
    for (int k0 = 0; k0 < K; k0 += 16) {
#pragma unroll
        for (int i = 0; i < 4; ++i) { const int idx = threadIdx.x + i * 256; const int r = idx >> 4, c = idx & 15; As[c][r] = A[(size_t)(m0 + r) * lda + k0 + c]; }
        if (TB) {
#pragma unroll
            for (int i = 0; i < 4; ++i) { const int idx = threadIdx.x + i * 256; const int r = idx >> 4, c = idx & 15; Bs[c][r] = B[(size_t)(n0 + r) * ldb + k0 + c]; }
        } else {
#pragma unroll
            for (int i = 0; i < 4; ++i) { const int idx = threadIdx.x + i * 256; const int r = idx >> 6, c = idx & 63; Bs[r][c] = B[(size_t)(k0 + r) * ldb + n0 + c]; }
        }
        __syncthreads();
#pragma unroll
        for (int kk = 0; kk < 16; ++kk) {
            float a[4], b[4];
#pragma unroll
            for (int i = 0; i < 4; ++i) { a[i] = As[kk][ty * 4 + i]; b[i] = Bs[kk][tx * 4 + i]; }
#pragma unroll
            for (int i = 0; i < 4; ++i)
#pragma unroll
                for (int j = 0; j < 4; ++j) acc[i][j] += a[i] * b[j];
        }
        __syncthreads();
    }
#pragma unroll
    for (int i = 0; i < 4; ++i)
#pragma unroll
        for (int j = 0; j < 4; ++j) { float* p = C + (size_t)(m0 + ty * 4 + i) * ldc + n0 + tx * 4 + j; *p = accum ? (*p + acc[i][j]) : acc[i][j]; }
}

__global__ void nk_gelu_exact(float* z, size_t n) {
    for (size_t i = (size_t)blockIdx.x * blockDim.x + threadIdx.x; i < n; i += (size_t)gridDim.x * blockDim.x) { const float v = z[i]; z[i] = 0.5f * v * (1.0f + erff(v * 0.70710678118654752f)); }
}

__global__ void __launch_bounds__(256) nk_sgu(const float* Z, const float* ws_, const float* bs_, float* G2, int cl) {
    const int chunk = blockIdx.x, g = blockIdx.y, d = threadIdx.x;
    const float* w = ws_ + (size_t)g * CHUNK * CHUNK; const float* b = bs_ + (size_t)g * CHUNK;
    for (int t = 0; t < cl; ++t) {
        float acc = 0.f;
        for (int s = 0; s <= t; ++s) acc += w[t * CHUNK + s] * Z[(size_t)(chunk * cl + s) * 4096 + 2048 + g * 256 + d];
        acc += b[t];
        const size_t row = (size_t)(chunk * cl + t);
        G2[row * 2048 + g * 256 + d] = Z[row * 4096 + g * 256 + d] * acc;
    }
}

__device__ __forceinline__ float gelu_tanh_f(float x) { const float u = 0.7978845608028654f * (x + 0.044715f * x * x * x); return 0.5f * x * (1.0f + tanhf(u)); }
__global__ void nk_conv_gate(const float* A, const float* prev, const float* cw, const float* cb, float* GU, float* newconv, int nb, int T) {
    const size_t total = (size_t)nb * T * D_FF;
    for (size_t i = (size_t)blockIdx.x * blockDim.x + threadIdx.x; i < total; i += (size_t)gridDim.x * blockDim.x) {
        const int j = (int)(i % D_FF); const size_t row = i / D_FF; const int t = (int)(row % T), b = (int)(row / T);
        float c2[2];
#pragma unroll
        for (int half = 0; half < 2; ++half) {
            const int col = j + half * D_FF; float c = cb[col];
#pragma unroll
            for (int k = 0; k < 3; ++k) { const int tt = t + k - 2; float v;
                if (tt >= 0) v = A[((size_t)b * T + tt) * FF2 + col]; else v = prev ? prev[((size_t)b * 2 + (tt + 2)) * FF2 + col] : 0.f;
                c += v * cw[k * FF2 + col]; }
            c2[half] = c; }
        GU[row * D_FF + j] = gelu_tanh_f(c2[0]) * c2[1];
    }
    const size_t tot2 = (size_t)nb * 2 * FF2;
    for (size_t i = (size_t)blockIdx.x * blockDim.x + threadIdx.x; i < tot2; i += (size_t)gridDim.x * blockDim.x) {
        const int col = (int)(i % FF2); const int r = (int)((i / FF2) % 2); const int b = (int)(i / (2 * FF2));
        const int tt = T - 2 + r; float v;
        if (tt >= 0) v = A[((size_t)b * T + tt) * FF2 + col]; else v = prev ? prev[((size_t)b * 2 + (tt + 2)) * FF2 + col] : 0.f;
        newconv[i] = v;
    }
}

__global__ void nk_rope(const float* X, int ldx, int col0, int cstride, int nblk, float* Y, int ldy, int ycol0, int ycstride, int M, int T, int pos0) {
    const size_t total = (size_t)M * nblk * 32;
    for (size_t i = (size_t)blockIdx.x * blockDim.x + threadIdx.x; i < total; i += (size_t)gridDim.x * blockDim.x) {
        const int k = (int)(i % 32); const int blk = (int)((i / 32) % nblk); const size_t row = i / (32 * nblk);
        const int pos = pos0 + (int)(row % T);
        const float inv = 1.0f / powf(10000.0f, (float)k / 32.0f);
        const float ang = (float)pos * inv;
        float sn, cs; sincosf(ang, &sn, &cs);
        const float x1 = X[row * ldx + col0 + blk * cstride + k], x2 = X[row * ldx + col0 + blk * cstride + k + 32];
        Y[row * ldy + ycol0 + blk * ycstride + k] = x1 * cs - x2 * sn;
        Y[row * ldy + ycol0 + blk * ycstride + k + 32] = x2 * cs + x1 * sn;
    }
}
__global__ void nk_copy2d(const float* X, int ldx, float* Y, int ldy, int rows, int cols) {
    const size_t total = (size_t)rows * cols;
    for (size_t i = (size_t)blockIdx.x * blockDim.x + threadIdx.x; i < total; i += (size_t)gridDim.x * blockDim.x) { const size_t r = i / cols; const int c = (int)(i % cols); Y[r * ldy + c] = X[r * ldx + c]; }
}
__global__ void __launch_bounds__(256) nk_softmax_causal(float* S, int T, float scale) {
    __shared__ float red[4];
    const int t = blockIdx.x; float* r = S + (size_t)t * T;
    float mx = -3.0e38f;
    for (int s = threadIdx.x; s <= t; s += 256) mx = fmaxf(mx, r[s] * scale);
    mx = block_max_256(mx, red);
    float sum = 0.f;
    for (int s = threadIdx.x; s < T; s += 256) { float p = 0.f; if (s <= t) p = __expf(r[s] * scale - mx); r[s] = p; sum += p; }
    sum = block_sum_256(sum, red);
    const float inv = 1.0f / sum;
    for (int s = threadIdx.x; s <= t; s += 256) r[s] *= inv;
}

constexpr int SKEYS = PAST_LEN + 1, SLD = 8200;
__global__ void __launch_bounds__(256) nk_sattn_scores(const float* QL, const float* QP, const float* cache_ckv, const float* cache_kr, const int* page_table, const float* CKVn, const float* KRn, float* Ss, float scale) {
    __shared__ float q[8][320];
    const int b = blockIdx.x;
    for (int i = threadIdx.x; i < 8 * 320; i += 256) { const int h = i / 320, c = i % 320; q[h][c] = c < 256 ? QL[((size_t)b * 8 + h) * 256 + c] : QP[((size_t)b * 8 + h) * 64 + (c - 256)]; }
    __syncthreads();
    for (int key = threadIdx.x; key < SKEYS; key += 256) {
        const float *cr, *kr;
        if (key < PAST_LEN) { const int page = page_table[b * NPAGES + key / PAGE]; const size_t slot = (size_t)page * PAGE + (key % PAGE); cr = cache_ckv + slot * KV_LORA; kr = cache_kr + slot * QK_ROPE; }
        else { cr = CKVn + (size_t)b * KV_LORA; kr = KRn + (size_t)b * QK_ROPE; }
        float acc[8];
#pragma unroll
        for (int h = 0; h < 8; ++h) acc[h] = 0.f;
        for (int c = 0; c < 256; ++c) { const float kv = cr[c];
#pragma unroll
            for (int h = 0; h < 8; ++h) acc[h] += q[h][c] * kv; }
        for (int c = 0; c < 64; ++c) { const float kv = kr[c];
#pragma unroll
            for (int h = 0; h < 8; ++h) acc[h] += q[h][256 + c] * kv; }
#pragma unroll
        for (int h = 0; h < 8; ++h) Ss[((size_t)b * 8 + h) * SLD + key] = acc[h] * scale;
    }
}
__global__ void __launch_bounds__(256) nk_sattn_softmax(float* Ss) {
    __shared__ float red[4];
    float* r = Ss + (size_t)blockIdx.x * SLD;
    float mx = -3.0e38f;
    for (int s = threadIdx.x; s < SKEYS; s += 256) mx = fmaxf(mx, r[s]);
    mx = block_max_256(mx, red);
    float sum = 0.f;
    for (int s = threadIdx.x; s < SKEYS; s += 256) { const float p = __expf(r[s] - mx); r[s] = p; sum += p; }
    sum = block_sum_256(sum, red);
    const float inv = 1.0f / sum;
    for (int s = threadIdx.x; s < SKEYS; s += 256) r[s] *= inv;
}
__global__ void __launch_bounds__(256) nk_sattn_pv(const float* Ss, const float* cache_ckv, const int* page_table, const float* CKVn, float* OL) {
    const int b = blockIdx.x, c = threadIdx.x;
    float acc[8];
#pragma unroll
    for (int h = 0; h < 8; ++h) acc[h] = 0.f;
    for (int key = 0; key < SKEYS; ++key) {
        const float* cr;
        if (key < PAST_LEN) { const int page = page_table[b * NPAGES + key / PAGE]; cr = cache_ckv + ((size_t)page * PAGE + (key % PAGE)) * KV_LORA; } else cr = CKVn + (size_t)b * KV_LORA;
        const float v = cr[c];
#pragma unroll
        for (int h = 0; h < 8; ++h) acc[h] += Ss[((size_t)b * 8 + h) * SLD + key] * v;
    }
#pragma unroll
    for (int h = 0; h < 8; ++h) OL[((size_t)b * 8 + h) * 256 + c] = acc[h];
}

struct Ptrs {
    const float *x_prompt, *x_sample, *cache_ckv, *cache_kr, *state_conv; const int* page_table;
    const float *pre_mix_g, *post_mix_g, *pre_ffn_g, *post_ffn_g, *w_in_a, *sgu_g, *w_s, *b_s, *w_out_a, *kv_in_g, *w_dkv, *kv_g, *w_uk, *w_uv, *w_dq, *q_g, *w_uq, *w_o, *w_up, *conv_w, *conv_b, *w_down;
};
static void gemm(hipStream_t st, bool tb, const float* A, int lda, const float* B, int ldb, float* C, int ldc, int M, int N, int K, int accum = 0) {
    dim3 grid(N / 64, M / 64);
    if (tb) hipLaunchKernelGGL(nk_gemm<true>, grid, dim3(256), 0, st, A, lda, B, ldb, C, ldc, M, N, K, accum);
    else hipLaunchKernelGGL(nk_gemm<false>, grid, dim3(256), 0, st, A, lda, B, ldb, C, ldc, M, N, K, accum);
}

struct Bufs { float *X, *H, *Z, *G2, *MO, *A, *GU, *KV, *CKV, *KR, *CQ, *Q, *QL, *QP, *OL, *O, *S, *Ss; };

static void run_group_naive(hipStream_t st, const Ptrs& P, const Bufs& W, const float* xin, int nb, int T, int pos0, bool sample,
                            float* y, float* out_ckv, float* out_kr, float* out_conv, float* out_chunkv) {
    const int M = nb * T;
    hipMemcpyAsync(W.X, xin, (size_t)M * D_MODEL * 4, hipMemcpyDeviceToDevice, st);
    const float scale = 1.0f / sqrtf((float)(QK_NOPE + QK_ROPE));
    for (int layer = 0; layer < DEPTH; ++layer) {
        if (layer == N_A) {
            hipLaunchKernelGGL(nk_rmsnorm, dim3(M), dim3(256), 0, st, W.X, D_MODEL, P.kv_in_g, W.H, D_MODEL, D_MODEL);
            gemm(st, false, W.H, D_MODEL, P.w_dkv, 320, W.KV, 320, M, 320, D_MODEL);
            hipLaunchKernelGGL(nk_rmsnorm, dim3(M), dim3(256), 0, st, W.KV, 320, P.kv_g, W.CKV, KV_LORA, KV_LORA);
            hipLaunchKernelGGL(nk_rope, dim3(1024), dim3(256), 0, st, W.KV, 320, 256, 0, 1, W.KR, 64, 0, 0, M, T, pos0);
            hipMemcpyAsync(out_ckv, W.CKV, (size_t)M * KV_LORA * 4, hipMemcpyDeviceToDevice, st);
            hipMemcpyAsync(out_kr, W.KR, (size_t)M * QK_ROPE * 4, hipMemcpyDeviceToDevice, st);
        }
        hipLaunchKernelGGL(nk_rmsnorm, dim3(M), dim3(256), 0, st, W.X, D_MODEL, P.pre_mix_g + layer * D_MODEL, W.H, D_MODEL, D_MODEL);
        if (layer < N_A) {
            gemm(st, false, W.H, D_MODEL, P.w_in_a + (size_t)layer * D_MODEL * 4096, 4096, W.Z, 4096, M, 4096, D_MODEL);
            hipLaunchKernelGGL(nk_gelu_exact, dim3(2048), dim3(256), 0, st, W.Z, (size_t)M * 4096);
            hipLaunchKernelGGL(nk_rmsnorm, dim3(M), dim3(256), 0, st, W.Z + 2048, 4096, P.sgu_g + layer * 2048, W.Z + 2048, 4096, 2048);
            if (sample) hipLaunchKernelGGL(nk_copy2d, dim3(256), dim3(256), 0, st, W.Z + 2048, 4096, out_chunkv + (size_t)layer * M * 2048, 2048, M, 2048);
            const int cl = T >= CHUNK ? CHUNK : T;
            hipLaunchKernelGGL(nk_sgu, dim3(M / cl, 8), dim3(256), 0, st, W.Z, P.w_s + (size_t)layer * 8 * CHUNK * CHUNK, P.b_s + (size_t)layer * 8 * CHUNK, W.G2, cl);
            gemm(st, false, W.G2, 2048, P.w_out_a + (size_t)layer * 2048 * D_MODEL, D_MODEL, W.MO, D_MODEL, M, D_MODEL, 2048);
        } else {
            const int j = layer - N_A;
            gemm(st, false, W.H, D_MODEL, P.w_dq + (size_t)j * D_MODEL * Q_LORA, Q_LORA, W.Q  , Q_LORA, M, Q_LORA, D_MODEL);
            hipLaunchKernelGGL(nk_rmsnorm, dim3(M), dim3(256), 0, st, W.Q, Q_LORA, P.q_g + j * Q_LORA, W.CQ, Q_LORA, Q_LORA);
            gemm(st, false, W.CQ, Q_LORA, P.w_uq + (size_t)j * Q_LORA * 1536, 1536, W.Q, 1536, M, 1536, Q_LORA);
            hipLaunchKernelGGL(nk_rope, dim3(1024), dim3(256), 0, st, W.Q, 1536, 128, 192, 8, W.QP, 512, 0, 64, M, T, pos0);
            for (int h = 0; h < NH; ++h) gemm(st, true, W.Q + h * 192, 1536, P.w_uk + h * 128, 1024, W.QL + h * 256, 2048, M, 256, 128);
            if (!sample) {
                for (int b = 0; b < nb; ++b) for (int h = 0; h < NH; ++h) {
                    gemm(st, true, W.QL + (size_t)b * T * 2048 + h * 256, 2048, W.CKV + (size_t)b * T * 256, 256, W.S, T, T, T, 256, 0);
                    gemm(st, true, W.QP + (size_t)b * T * 512 + h * 64, 512, W.KR + (size_t)b * T * 64, 64, W.S, T, T, T, 64, 1);
                    hipLaunchKernelGGL(nk_softmax_causal, dim3(T), dim3(256), 0, st, W.S, T, scale);
                    gemm(st, false, W.S, T, W.CKV + (size_t)b * T * 256, 256, W.OL + (size_t)b * T * 2048 + h * 256, 2048, T, 256, T, 0);
                }
            } else {
                hipLaunchKernelGGL(nk_sattn_scores, dim3(MS), dim3(256), 0, st, W.QL, W.QP, P.cache_ckv, P.cache_kr, P.page_table, W.CKV, W.KR, W.Ss, scale);
                hipLaunchKernelGGL(nk_sattn_softmax, dim3(MS * 8), dim3(256), 0, st, W.Ss);
                hipLaunchKernelGGL(nk_sattn_pv, dim3(MS), dim3(256), 0, st, W.Ss, P.cache_ckv, P.page_table, W.CKV, W.OL);
            }
            for (int h = 0; h < NH; ++h) gemm(st, false, W.OL + h * 256, 2048, P.w_uv + h * 128, 1024, W.O + h * 128, 1024, M, 128, 256);
            gemm(st, false, W.O, 1024, P.w_o + (size_t)j * 1024 * 1024, 1024, W.MO, 1024, M, 1024, 1024);
        }
        hipLaunchKernelGGL(nk_resid_rmsnorm, dim3(M), dim3(256), 0, st, W.X, W.MO, P.post_mix_g + layer * D_MODEL, D_MODEL);
        hipLaunchKernelGGL(nk_rmsnorm, dim3(M), dim3(256), 0, st, W.X, D_MODEL, P.pre_ffn_g + layer * D_MODEL, W.H, D_MODEL, D_MODEL);
        gemm(st, false, W.H, D_MODEL, P.w_up + (size_t)layer * D_MODEL * FF2, FF2, W.A, FF2, M, FF2, D_MODEL);
        hipLaunchKernelGGL(nk_conv_gate, dim3(4096), dim3(256), 0, st, W.A, sample ? P.state_conv + (size_t)layer * nb * 2 * FF2 : (const float*)nullptr,
                           P.conv_w + (size_t)layer * 3 * FF2, P.conv_b + (size_t)layer * FF2, W.GU, out_conv + (size_t)layer * nb * 2 * FF2, nb, T);
        gemm(st, false, W.GU, D_FF, P.w_down + (size_t)layer * D_FF * D_MODEL, D_MODEL, W.MO, D_MODEL, M, D_MODEL, D_FF);
        hipLaunchKernelGGL(nk_resid_rmsnorm, dim3(M), dim3(256), 0, st, W.X, W.MO, P.post_ffn_g + layer * D_MODEL, D_MODEL);
    }
    hipMemcpyAsync(y, W.X, (size_t)M * D_MODEL * 4, hipMemcpyDeviceToDevice, st);
}

extern "C" void kernel_launch(void* const* d_in, const int* in_sizes, int n_in, void* d_out, int out_size, void* d_ws, size_t ws_size, hipStream_t stream) {
    Ptrs P;
    P.x_prompt = (const float*)d_in[0]; P.x_sample = (const float*)d_in[1]; P.cache_ckv = (const float*)d_in[2]; P.cache_kr = (const float*)d_in[3]; P.state_conv = (const float*)d_in[4];
    P.page_table = (const int*)d_in[5]; P.pre_mix_g = (const float*)d_in[6]; P.post_mix_g = (const float*)d_in[7]; P.pre_ffn_g = (const float*)d_in[8]; P.post_ffn_g = (const float*)d_in[9];
    P.w_in_a = (const float*)d_in[10]; P.sgu_g = (const float*)d_in[11]; P.w_s = (const float*)d_in[12]; P.b_s = (const float*)d_in[13]; P.w_out_a = (const float*)d_in[14];
    P.kv_in_g = (const float*)d_in[15]; P.w_dkv = (const float*)d_in[16]; P.kv_g = (const float*)d_in[17]; P.w_uk = (const float*)d_in[18]; P.w_uv = (const float*)d_in[19];
    P.w_dq = (const float*)d_in[20]; P.q_g = (const float*)d_in[21]; P.w_uq = (const float*)d_in[22]; P.w_o = (const float*)d_in[23]; P.w_up = (const float*)d_in[24];
    P.conv_w = (const float*)d_in[25]; P.conv_b = (const float*)d_in[26]; P.w_down = (const float*)d_in[27];

    float* out = (float*)d_out;
    float* y_prompt = out; float* y_sample = y_prompt + (size_t)MP * D_MODEL; float* ckv_p = y_sample + (size_t)MS * D_MODEL; float* kr_p = ckv_p + (size_t)MP * KV_LORA;
    float* conv_p = kr_p + (size_t)MP * QK_ROPE; float* ckv_s = conv_p + (size_t)DEPTH * BATCH * 2 * FF2; float* kr_s = ckv_s + (size_t)MS * KV_LORA;
    float* conv_s = kr_s + (size_t)MS * QK_ROPE; float* chunkv_s = conv_s + (size_t)DEPTH * MS * 2 * FF2;

    float* w = (float*)d_ws; size_t off = 0;
    auto take = [&](size_t n) { float* p = w + off; off += (n + 63) & ~(size_t)63; return p; };
    Bufs W;
    W.X = take((size_t)MP * 1024); W.H = take((size_t)MP * 1024); W.Z = take((size_t)MP * 4096); W.G2 = take((size_t)MP * 2048); W.MO = take((size_t)MP * 1024);
    W.A = take((size_t)MP * FF2); W.GU = take((size_t)MP * D_FF); W.KV = take((size_t)MP * 320); W.CKV = take((size_t)MP * 256); W.KR = take((size_t)MP * 64);
    W.CQ = take((size_t)MP * 512); W.Q = take((size_t)MP * 1536); W.QL = take((size_t)MP * 2048); W.QP = take((size_t)MP * 512); W.OL = take((size_t)MP * 2048);
    W.O = take((size_t)MP * 1024); W.S = take((size_t)SEQ * SEQ); W.Ss = take((size_t)MS * 8 * SLD);
    if (off * 4 > ws_size) { fprintf(stderr, "workspace too small: need %zu have %zu\n", off * 4, ws_size); return; }

    run_group_naive(stream, P, W, P.x_prompt, BATCH, SEQ, 0, false, y_prompt, ckv_p, kr_p, conv_p, nullptr);
    run_group_naive(stream, P, W, P.x_sample, DEC_BATCH, 1, PAST_LEN, true, y_sample, ckv_s, kr_s, conv_s, chunkv_s);
}
```

```cpp
#include <hip/hip_runtime.h>
#include <cstdio>
#include <cstdint>

constexpr int D_MODEL = 1024, BATCH = 8, SEQ = 2048, DEPTH = 4, DEC_BATCH = 128, PAST_LEN = 8192, PAGE = 128;
constexpr int N_A = 2, CHUNK = 128, SGU_W = 2048, SGU_G = 8, SGU_GD = 256;
constexpr int NH = 8, QK_NOPE = 128, QK_ROPE = 64, V_HEAD = 128, Q_LORA = 512, KV_LORA = 256;
constexpr int D_FF = 2816, FF2 = 5632;
constexpr float EPS = 1e-6f;
constexpr int MP = BATCH * SEQ;
constexpr int MS = DEC_BATCH;
constexpr int NPAGES = PAST_LEN / PAGE;

__device__ __forceinline__ float block_sum_256(float v, float* red) {
    for (int o = 32; o >= 1; o >>= 1) v += __shfl_xor(v, o);
    const int w = threadIdx.x >> 6;
    __syncthreads();
    if ((threadIdx.x & 63) == 0) red[w] = v;
    __syncthreads();
    float s = red[0] + red[1] + red[2] + red[3];
    return s;
}
__device__ __forceinline__ float block_max_256(float v, float* red) {
    for (int o = 32; o >= 1; o >>= 1) v = fmaxf(v, __shfl_xor(v, o));
    const int w = threadIdx.x >> 6;
    __syncthreads();
    if ((threadIdx.x & 63) == 0) red[w] = v;
    __syncthreads();
    return fmaxf(fmaxf(red[0], red[1]), fmaxf(red[2], red[3]));
}

__global__ void __launch_bounds__(256) nk_rmsnorm(const float* in, int ldi, const float* g, float* out, int ldo, int D) {
    __shared__ float red[4];
    const float* r = in + (size_t)blockIdx.x * ldi; float* o = out + (size_t)blockIdx.x * ldo;
    float s = 0.f;
    for (int i = threadIdx.x; i < D; i += 256) { const float v = r[i]; s += v * v; }
    s = block_sum_256(s, red);
    const float rstd = rsqrtf(s / (float)D + EPS);
    for (int i = threadIdx.x; i < D; i += 256) o[i] = r[i] * rstd * g[i];
}
__global__ void __launch_bounds__(256) nk_resid_rmsnorm(float* x, const float* m, const float* g, int D) {
    __shared__ float red[4];
    const float* r = m + (size_t)blockIdx.x * D; float* o = x + (size_t)blockIdx.x * D;
    float s = 0.f;
    for (int i = threadIdx.x; i < D; i += 256) { const float v = r[i]; s += v * v; }
    s = block_sum_256(s, red);
    const float rstd = rsqrtf(s / (float)D + EPS);
    for (int i = threadIdx.x; i < D; i += 256) o[i] += r[i] * rstd * g[i];
}

template <bool TB>
__global__ void __launch_bounds__(256) nk_gemm(const float* __restrict__ A, int lda, const float* __restrict__ B, int ldb, float* C, int ldc, int M, int N, int K, int accum) {
    __shared__ float As[16][65];
    __shared__ float Bs[16][65];
    const int tx = threadIdx.x & 15, ty = threadIdx.x >> 4;
    const int m0 = blockIdx.y * 64, n0 = blockIdx.x * 64;
    float acc[4][4];
#pragma unroll
    for (int i = 0; i < 4; ++i)
#pragma unroll
        for (int j = 0; j < 4; ++j) acc[i][j] = 0.f;
    for (int k0 = 0; k0 < K; k0 += 16) {
#pragma unroll
        for (int i = 0; i < 4; ++i) { const int idx = threadIdx.x + i * 256; const int r = idx >> 4, c = idx & 15; As[c][r] = A[(size_t)(m0 + r) * lda + k0 + c]; }
        if (TB) {
#pragma unroll
            for (int i = 0; i < 4; ++i) { const int idx = threadIdx.x + i * 256; const int r = idx >> 4, c = idx & 15; Bs[c][r] = B[(size_t)(n0 + r) * ldb + k0 + c]; }
        } else {
#pragma unroll
            for (int i = 0; i < 4; ++i) { const int idx = threadIdx.x + i * 256; const int r = idx >> 6, c = idx & 63; Bs[r][c] = B[(size_t)(k0 + r) * ldb + n0 + c]; }
        }
        __syncthreads();
#pragma unroll
        for (int kk = 0; kk < 16; ++kk) {
            float a[4], b[4];
#pragma unroll
            for (int i = 0; i < 4; ++i) { a[i] = As[kk][ty * 4 + i]; b[i] = Bs[kk][tx * 4 + i]; }
#pragma unroll
            for (int i = 0; i < 4; ++i)
#pragma unroll
                for (int j = 0; j < 4; ++j) acc[i][j] += a[i] * b[j];
        }
        __syncthreads();
    }
#pragma unroll
    for (int i = 0; i < 4; ++i)
#pragma unroll
        for (int j = 0; j < 4; ++j) { float* p = C + (size_t)(m0 + ty * 4 + i) * ldc + n0 + tx * 4 + j; *p = accum ? (*p + acc[i][j]) : acc[i][j]; }
}

__global__ void nk_gelu_exact(float* z, size_t n) {
    for (size_t i = (size_t)blockIdx.x * blockDim.x + threadIdx.x; i < n; i += (size_t)gridDim.x * blockDim.x) { const float v = z[i]; z[i] = 0.5f * v * (1.0f + erff(v * 0.70710678118654752f)); }
}

__global__ void __launch_bounds__(256) nk_sgu(const float* Z, const float* ws_, const float* bs_, float* G2, int cl) {
    const int chunk = blockIdx.x, g = blockIdx.y, d = threadIdx.x;
    const float* w = ws_ + (size_t)g * CHUNK * CHUNK; const float* b = bs_ + (size_t)g * CHUNK;
    for (int t = 0; t < cl; ++t) {
        float acc = 0.f;
        for (int s = 0; s <= t; ++s) acc += w[t * CHUNK + s] * Z[(size_t)(chunk * cl + s) * 4096 + 2048 + g * 256 + d];
        acc += b[t];
        const size_t row = (size_t)(chunk * cl + t);
        G2[row * 2048 + g * 256 + d] = Z[row * 4096 + g * 256 + d] * acc;
    }
}

__device__ __forceinline__ float gelu_tanh_f(float x) { const float u = 0.7978845608028654f * (x + 0.044715f * x * x * x); return 0.5f * x * (1.0f + tanhf(u)); }
__global__ void nk_conv_gate(const float* A, const float* prev, const float* cw, const float* cb, float* GU, float* newconv, int nb, int T) {
    const size_t total = (size_t)nb * T * D_FF;
    for (size_t i = (size_t)blockIdx.x * blockDim.x + threadIdx.x; i < total; i += (size_t)gridDim.x * blockDim.x) {
        const int j = (int)(i % D_FF); const size_t row = i / D_FF; const int t = (int)(row % T), b = (int)(row / T);
        float c2[2];
#pragma unroll
        for (int half = 0; half < 2; ++half) {
            const int col = j + half * D_FF; float c = cb[col];
#pragma unroll
            for (int k = 0; k < 3; ++k) { const int tt = t + k - 2; float v;
                if (tt >= 0) v = A[((size_t)b * T + tt) * FF2 + col]; else v = prev ? prev[((size_t)b * 2 + (tt + 2)) * FF2 + col] : 0.f;
                c += v * cw[k * FF2 + col]; }
            c2[half] = c; }
        GU[row * D_FF + j] = gelu_tanh_f(c2[0]) * c2[1];
    }
    const size_t tot2 = (size_t)nb * 2 * FF2;
    for (size_t i = (size_t)blockIdx.x * blockDim.x + threadIdx.x; i < tot2; i += (size_t)gridDim.x * blockDim.x) {
        const int col = (int)(i % FF2); const int r = (int)((i / FF2) % 2); const int b = (int)(i / (2 * FF2));
        const int tt = T - 2 + r; float v;
        if (tt >= 0) v = A[((size_t)b * T + tt) * FF2 + col]; else v = prev ? prev[((size_t)b * 2 + (tt + 2)) * FF2 + col] : 0.f;
        newconv[i] = v;
    }
}

__global__ void nk_rope(const float* X, int ldx, int col0, int cstride, int nblk, float* Y, int ldy, int ycol0, int ycstride, int M, int T, int pos0) {
    const size_t total = (size_t)M * nblk * 32;
    for (size_t i = (size_t)blockIdx.x * blockDim.x + threadIdx.x; i < total; i += (size_t)gridDim.x * blockDim.x) {
        const int k = (int)(i % 32); const int blk = (int)((i / 32) % nblk); const size_t row = i / (32 * nblk);
        const int pos = pos0 + (int)(row % T);
        const float inv = 1.0f / powf(10000.0f, (float)k / 32.0f);
        const float ang = (float)pos * inv;
        float sn, cs; sincosf(ang, &sn, &cs);
        const float x1 = X[row * ldx + col0 + blk * cstride + k], x2 = X[row * ldx + col0 + blk * cstride + k + 32];
        Y[row * ldy + ycol0 + blk * ycstride + k] = x1 * cs - x2 * sn;
        Y[row * ldy + ycol0 + blk * ycstride + k + 32] = x2 * cs + x1 * sn;
    }
}
__global__ void nk_copy2d(const float* X, int ldx, float* Y, int ldy, int rows, int cols) {
    const size_t total = (size_t)rows * cols;
    for (size_t i = (size_t)blockIdx.x * blockDim.x + threadIdx.x; i < total; i += (size_t)gridDim.x * blockDim.x) { const size_t r = i / cols; const int c = (int)(i % cols); Y[r * ldy + c] = X[r * ldx + c]; }
}
__global__ void __launch_bounds__(256) nk_softmax_causal(float* S, int T, float scale) {
    __shared__ float red[4];
    const int t = blockIdx.x; float* r = S + (size_t)t * T;
    float mx = -3.0e38f;
    for (int s = threadIdx.x; s <= t; s += 256) mx = fmaxf(mx, r[s] * scale);
    mx = block_max_256(mx, red);
    float sum = 0.f;
    for (int s = threadIdx.x; s < T; s += 256) { float p = 0.f; if (s <= t) p = __expf(r[s] * scale - mx); r[s] = p; sum += p; }
    sum = block_sum_256(sum, red);
    const float inv = 1.0f / sum;
    for (int s = threadIdx.x; s <= t; s += 256) r[s] *= inv;
}

constexpr int SKEYS = PAST_LEN + 1, SLD = 8200;
__global__ void __launch_bounds__(256) nk_sattn_scores(const float* QL, const float* QP, const float* cache_ckv, const float* cache_kr, const int* page_table, const float* CKVn, const float* KRn, float* Ss, float scale) {
    __shared__ float q[8][320];
    const int b = blockIdx.x;
    for (int i = threadIdx.x; i < 8 * 320; i += 256) { const int h = i / 320, c = i % 320; q[h][c] = c < 256 ? QL[((size_t)b * 8 + h) * 256 + c] : QP[((size_t)b * 8 + h) * 64 + (c - 256)]; }
    __syncthreads();
    for (int key = threadIdx.x; key < SKEYS; key += 256) {
        const float *cr, *kr;
        if (key < PAST_LEN) { const int page = page_table[b * NPAGES + key / PAGE]; const size_t slot = (size_t)page * PAGE + (key % PAGE); cr = cache_ckv + slot * KV_LORA; kr = cache_kr + slot * QK_ROPE; }
        else { cr = CKVn + (size_t)b * KV_LORA; kr = KRn + (size_t)b * QK_ROPE; }
        float acc[8];
#pragma unroll
        for (int h = 0; h < 8; ++h) acc[h] = 0.f;
        for (int c = 0; c < 256; ++c) { const float kv = cr[c];
#pragma unroll
            for (int h = 0; h < 8; ++h) acc[h] += q[h][c] * kv; }
        for (int c = 0; c < 64; ++c) { const float kv = kr[c];
#pragma unroll
            for (int h = 0; h < 8; ++h) acc[h] += q[h][256 + c] * kv; }
#pragma unroll
        for (int h = 0; h < 8; ++h) Ss[((size_t)b * 8 + h) * SLD + key] = acc[h] * scale;
    }
}
__global__ void __launch_bounds__(256) nk_sattn_softmax(float* Ss) {
    __shared__ float red[4];
    float* r = Ss + (size_t)blockIdx.x * SLD;
    float mx = -3.0e38f;
    for (int s = threadIdx.x; s < SKEYS; s += 256) mx = fmaxf(mx, r[s]);
    mx = block_max_256(mx, red);
    float sum = 0.f;
    for (int s = threadIdx.x; s < SKEYS; s += 256) { const float p = __expf(r[s] - mx); r[s] = p; sum += p; }
    sum = block_sum_256(sum, red);
    const float inv = 1.0f / sum;
    for (int s = threadIdx.x; s < SKEYS; s += 256) r[s] *= inv;
}
__global__ void __launch_bounds__(256) nk_sattn_pv(const float* Ss, const float* cache_ckv, const int* page_table, const float* CKVn, float* OL) {
    const int b = blockIdx.x, c = threadIdx.x;
    float acc[8];
#pragma unroll
    for (int h = 0; h < 8; ++h) acc[h] = 0.f;
    for (int key = 0; key < SKEYS; ++key) {
        const float* cr;
        if (key < PAST_LEN) { const int page = page_table[b * NPAGES + key / PAGE]; cr = cache_ckv + ((size_t)page * PAGE + (key % PAGE)) * KV_LORA; } else cr = CKVn + (size_t)b * KV_LORA;
        const float v = cr[c];
#pragma unroll
        for (int h = 0; h < 8; ++h) acc[h] += Ss[((size_t)b * 8 + h) * SLD + key] * v;
    }
#pragma unroll
    for (int h = 0; h < 8; ++h) OL[((size_t)b * 8 + h) * 256 + c] = acc[h];
}

namespace pg8 {
#define PG8_LAS __attribute__((address_space(3)))
typedef unsigned short bf16_t;
typedef short bf16x8 __attribute__((ext_vector_type(8)));
typedef float f32x4 __attribute__((ext_vector_type(4)));
typedef unsigned u32x4 __attribute__((ext_vector_type(4)));
constexpr int BM = 256, BK = 64, HALF = 128, HTB = HALF * BK * 2  , STAGE_BYTES = 8 * HTB, NXCD = 8, WGM = 8;

__host__ __device__ __forceinline__ int lds_byte(int r, int c) { const int st = (r >> 4) * 2 + (c >> 5), rr = r & 15, cc = c & 31, ob = rr * 64 + cc * 2; return st * 1024 + (ob ^ (((ob >> 9) & 1) << 5)); }
__host__ __device__ __forceinline__ void stage_rc(int b, int& R, int& C) { const int st = b / 1024, sb = b % 1024, swz = sb ^ (((sb >> 9) & 1) << 5); R = (st >> 1) * 16 + swz / 64; C = (st & 1) * 32 + (swz % 64) / 2; }
__host__ __device__ __forceinline__ int perm32(int rho) { const int n = rho >> 4, i = rho & 15; return 8 * (i >> 2) + 4 * n + (i & 3); }

struct Unit { int pm, pn; };
struct Gemm { const bf16_t* A; const bf16_t* Bt; int M, N, K; };

struct StaticOrder {
    int nM, nN, nwg, G, c;
    __host__ __device__ void init(int M, int N, int G_, int c_) { nM = M / BM; nN = N / BM; nwg = nM * nN; G = G_; c = c_; }
    __host__ __device__ bool next(int i, Unit& u) const {
        const long L = (long)i * G + c; if (L >= nwg) return false;
        int wgid = (int)L; { const int q = nwg / NXCD, r = nwg % NXCD, xcd = wgid % NXCD, off = wgid / NXCD; wgid = (xcd < r ? xcd * (q + 1) : r * (q + 1) + (xcd - r) * q) + off; }
        const int nig = WGM * nN, gid = wgid / nig, fm = gid * WGM, gsz = (nM - fm) < WGM ? (nM - fm) : WGM;
        u.pm = fm + ((wgid % nig) % gsz); u.pn = (wgid % nig) / gsz; return true;
    }
    __device__ __forceinline__ void a_ready(const Unit&) const {}
    __device__ __forceinline__ void done(const Unit&) const {}
};

__device__ __forceinline__ unsigned cvt_pk_bf16(float lo, float hi) { unsigned r; asm volatile("v_cvt_pk_bf16_f32 %0, %1, %2" : "=v"(r) : "v"(lo), "v"(hi)); return r; }
typedef float f32x2 __attribute__((ext_vector_type(2)));
__device__ __forceinline__ f32x2 gelu_pk(f32x2 v) {
    const f32x2 av = __builtin_elementwise_abs(v), d = av * 0.2316418882f + 1.0f;
    f32x2 t; t.x = __builtin_amdgcn_rcpf(d.x); t.y = __builtin_amdgcn_rcpf(d.y);
    f32x2 q = t * 0.5307027145f + (-0.7265760135f); q = q * t + 0.7107068705f; q = q * t + (-0.142248368f); q = q * t + 0.127414796f; q = q * t;
    const f32x2 s = (v * v) * (-0.72134752044f);
    f32x2 e; e.x = __builtin_amdgcn_exp2f(s.x); e.y = __builtin_amdgcn_exp2f(s.y);
    const f32x2 m = v * (q * e), r = v - m;
    f32x2 o; o.x = v.x < 0.f ? m.x : r.x; o.y = v.y < 0.f ? m.y : r.y; return o;
}

__device__ __forceinline__ float half_reduce_fq(float s) { s += __shfl_xor(s, 16); s += __shfl_xor(s, 32); return s; }
struct EpiF32SS {
    static constexpr bool PERM = false, AFTER_DRAIN = false;
    float* C; int ldc; float* ss; int ssld;
    __device__ __forceinline__ void operator()(const f32x4 (&acc)[2][2][4][2], const Unit& u, int wr, int wc, int fr, int fq) const {
        const int row0 = u.pm * BM + wr * 64 + fr, col0 = u.pn * BM + wc * 32 + 4 * fq;
#pragma unroll
        for (int ai = 0; ai < 2; ++ai)
#pragma unroll
            for (int m = 0; m < 4; ++m) { const int row = row0 + ai * HALF + m * 16; float* rowp = C + (size_t)row * ldc + col0; float s = 0.f;
#pragma unroll
                for (int bj = 0; bj < 2; ++bj)
#pragma unroll
                    for (int n = 0; n < 2; ++n) { const f32x4 v = acc[ai][bj][m][n]; *(f32x4*)(rowp + bj * HALF + n * 16) = v; s += (v[0] * v[0] + v[1] * v[1]) + (v[2] * v[2] + v[3] * v[3]); }
                s = half_reduce_fq(s);
                if (fq == 0) ss[(size_t)row * ssld + u.pn * 4 + wc] = s; }
    }
};
struct EpiZ {
    static constexpr bool PERM = true, AFTER_DRAIN = false;
    bf16_t* U; bf16_t* V; const float* rstd; float* vss;
    __device__ __forceinline__ void operator()(const f32x4 (&acc)[2][2][4][2], const Unit& u, int wr, int wc, int fr, int fq) const {
        const int row0 = u.pm * BM + wr * 64 + fr; const bool isv = u.pn >= 8; bf16_t* base = isv ? V : U; const int col0 = (u.pn & 7) * BM + wc * 32 + 8 * fq;
#pragma unroll
        for (int ai = 0; ai < 2; ++ai)
#pragma unroll
            for (int m = 0; m < 4; ++m) { const int row = row0 + ai * HALF + m * 16; const float rs = rstd[row]; bf16_t* rowp = base + (size_t)row * 2048 + col0; float s = 0.f;
#pragma unroll
                for (int bj = 0; bj < 2; ++bj) { f32x4 v0 = acc[ai][bj][m][0] * rs, v1 = acc[ai][bj][m][1] * rs;
                    { f32x2 a = gelu_pk((f32x2){v0[0], v0[1]}), b = gelu_pk((f32x2){v0[2], v0[3]}), c = gelu_pk((f32x2){v1[0], v1[1]}), d = gelu_pk((f32x2){v1[2], v1[3]});
                      v0 = (f32x4){a.x, a.y, b.x, b.y}; v1 = (f32x4){c.x, c.y, d.x, d.y}; }
                    s += (v0[0] * v0[0] + v0[1] * v0[1]) + (v0[2] * v0[2] + v0[3] * v0[3]) + (v1[0] * v1[0] + v1[1] * v1[1]) + (v1[2] * v1[2] + v1[3] * v1[3]);
                    u32x4 w; w.x = cvt_pk_bf16(v0[0], v0[1]); w.y = cvt_pk_bf16(v0[2], v0[3]); w.z = cvt_pk_bf16(v1[0], v1[1]); w.w = cvt_pk_bf16(v1[2], v1[3]);
                    *(u32x4*)(rowp + bj * HALF) = w; }
                if (isv) { s = half_reduce_fq(s); if (fq == 0) vss[(size_t)row * 32 + (u.pn - 8) * 4 + wc] = s; } }
    }
};
struct EpiUp {
    static constexpr bool PERM = true, AFTER_DRAIN = false;
    bf16_t* AB; const float* rstd; float* conv_out;
    __device__ __forceinline__ void operator()(const f32x4 (&acc)[2][2][4][2], const Unit& u, int wr, int wc, int fr, int fq) const {
        const int row0 = u.pm * BM + wr * 64 + fr, col0 = u.pn * BM + wc * 32 + 8 * fq;
#pragma unroll
        for (int ai = 0; ai < 2; ++ai)
#pragma unroll
            for (int m = 0; m < 4; ++m) { const int row = row0 + ai * HALF + m * 16; const float rs = rstd[row]; bf16_t* rowp = AB + (size_t)row * 5632 + col0; const int t = row & 2047;
#pragma unroll
                for (int bj = 0; bj < 2; ++bj) { const f32x4 v0 = acc[ai][bj][m][0] * rs, v1 = acc[ai][bj][m][1] * rs;
                    u32x4 w; w.x = cvt_pk_bf16(v0[0], v0[1]); w.y = cvt_pk_bf16(v0[2], v0[3]); w.z = cvt_pk_bf16(v1[0], v1[1]); w.w = cvt_pk_bf16(v1[2], v1[3]);
                    *(u32x4*)(rowp + bj * HALF) = w;
                    if (t >= 2046) { float* o = conv_out + ((size_t)(row >> 11) * 2 + (t - 2046)) * 5632 + col0 + bj * HALF; *(f32x4*)o = v0; *(f32x4*)(o + 4) = v1; } } }
    }
};
struct EpiDq {
    static constexpr bool PERM = true, AFTER_DRAIN = false;
    bf16_t* CQ; const float* rstd; float* cqss; float* KVR;
    __device__ __forceinline__ void operator()(const f32x4 (&acc)[2][2][4][2], const Unit& u, int wr, int wc, int fr, int fq) const {
        const int row0 = u.pm * BM + wr * 64 + fr, col0 = u.pn * BM + wc * 32 + 8 * fq; const bool iscq = u.pn < 2;
#pragma unroll
        for (int ai = 0; ai < 2; ++ai)
#pragma unroll
            for (int m = 0; m < 4; ++m) { const int row = row0 + ai * HALF + m * 16; const float rs = rstd[row]; float s = 0.f;
#pragma unroll
                for (int bj = 0; bj < 2; ++bj) { const f32x4 v0 = acc[ai][bj][m][0] * rs, v1 = acc[ai][bj][m][1] * rs; const int c = col0 + bj * HALF;
                    if (iscq) { s += (v0[0] * v0[0] + v0[1] * v0[1]) + (v0[2] * v0[2] + v0[3] * v0[3]) + (v1[0] * v1[0] + v1[1] * v1[1]) + (v1[2] * v1[2] + v1[3] * v1[3]);
                        u32x4 w; w.x = cvt_pk_bf16(v0[0], v0[1]); w.y = cvt_pk_bf16(v0[2], v0[3]); w.z = cvt_pk_bf16(v1[0], v1[1]); w.w = cvt_pk_bf16(v1[2], v1[3]);
                        *(u32x4*)(CQ + (size_t)row * 512 + c) = w; }
                    else if (c - 512 < 320) { float* o = KVR + (size_t)row * 320 + (c - 512); *(f32x4*)o = v0; *(f32x4*)(o + 4) = v1; } }
                if (iscq) { s = half_reduce_fq(s); if (fq == 0) cqss[(size_t)row * 8 + u.pn * 4 + wc] = s; } }
    }
};
struct EpiQ {
    static constexpr bool PERM = true, AFTER_DRAIN = false;
    bf16_t* Q; const float* cqss; const float* rope;
    __device__ __forceinline__ void operator()(const f32x4 (&acc)[2][2][4][2], const Unit& u, int wr, int wc, int fr, int fq) const {
        const int row0 = u.pm * BM + wr * 64 + fr, col0 = u.pn * BM + wc * 32 + 8 * fq;
#pragma unroll
        for (int ai = 0; ai < 2; ++ai)
#pragma unroll
            for (int m = 0; m < 4; ++m) { const int row = row0 + ai * HALF + m * 16; const f32x4 p0 = *(const f32x4*)(cqss + (size_t)row * 8), p1 = *(const f32x4*)(cqss + (size_t)row * 8 + 4);
                const float rs = rsqrtf(((p0[0] + p0[1]) + (p0[2] + p0[3]) + (p1[0] + p1[1]) + (p1[2] + p1[3])) * (1.0f / 512.0f) + 1e-6f); const int pos = row & 2047;
#pragma unroll
                for (int bj = 0; bj < 2; ++bj) { f32x4 v0 = acc[ai][bj][m][0] * rs, v1 = acc[ai][bj][m][1] * rs; const int c = col0 + bj * HALF; const int cin = c % 192;
                    if (cin >= 128) { const int i0 = (cin - 128) >> 1; const f32x4 t0 = *(const f32x4*)(rope + ((size_t)pos * 32 + i0) * 2), t1 = *(const f32x4*)(rope + ((size_t)pos * 32 + i0 + 2) * 2);
                        const f32x4 a = v0, b = v1;
                        v0[0] = a[0] * t0[0] - a[1] * t0[1]; v0[1] = a[1] * t0[0] + a[0] * t0[1]; v0[2] = a[2] * t0[2] - a[3] * t0[3]; v0[3] = a[3] * t0[2] + a[2] * t0[3];
                        v1[0] = b[0] * t1[0] - b[1] * t1[1]; v1[1] = b[1] * t1[0] + b[0] * t1[1]; v1[2] = b[2] * t1[2] - b[3] * t1[3]; v1[3] = b[3] * t1[2] + b[2] * t1[3]; }
                    u32x4 w; w.x = cvt_pk_bf16(v0[0], v0[1]); w.y = cvt_pk_bf16(v0[2], v0[3]); w.z = cvt_pk_bf16(v1[0], v1[1]); w.w = cvt_pk_bf16(v1[2], v1[3]);
                    *(u32x4*)(Q + (size_t)row * 1536 + c) = w; } }
    }
};
struct EpiBf {
    static constexpr bool PERM = true, AFTER_DRAIN = false;
    bf16_t* O; int ldc;
    __device__ __forceinline__ void operator()(const f32x4 (&acc)[2][2][4][2], const Unit& u, int wr, int wc, int fr, int fq) const {
        const int row0 = u.pm * BM + wr * 64 + fr, col0 = u.pn * BM + wc * 32 + 8 * fq;
#pragma unroll
        for (int ai = 0; ai < 2; ++ai)
#pragma unroll
            for (int m = 0; m < 4; ++m) { bf16_t* rowp = O + (size_t)(row0 + ai * HALF + m * 16) * ldc + col0;
#pragma unroll
                for (int bj = 0; bj < 2; ++bj) { const f32x4 v0 = acc[ai][bj][m][0], v1 = acc[ai][bj][m][1];
                    u32x4 w; w.x = cvt_pk_bf16(v0[0], v0[1]); w.y = cvt_pk_bf16(v0[2], v0[3]); w.z = cvt_pk_bf16(v1[0], v1[1]); w.w = cvt_pk_bf16(v1[2], v1[3]);
                    *(u32x4*)(rowp + bj * HALF) = w; } }
    }
};
template <class Epi, class Sched, bool ALIGN_EPI = false, bool SP2 = false>
__device__ __forceinline__ void gemm_phase(PG8_LAS unsigned char* lds, const Gemm g, const Sched& S, const Epi& E) {
    int tid_ = threadIdx.x; asm volatile("" : "+v"(tid_));
    const int tid = tid_, wid = __builtin_amdgcn_readfirstlane(tid >> 6), lane = tid & 63, wr = wid >> 2, wc = wid & 3, fr = lane & 15, fq = lane >> 4;
    const int K = g.K, nt = K / BK;
    unsigned voffA[2], voffB[2];
#pragma unroll
    for (int i = 0; i < 2; ++i) { int R, C; stage_rc(tid * 16 + i * 8192, R, C); const int Rb = Epi::PERM ? ((R & ~31) + perm32(R & 31)) : R;
        voffA[i] = (unsigned)(R * K + C) * 2u; voffB[i] = (unsigned)(Rb * K + C) * 2u; }
    const size_t kstep = (size_t)(BK * 2);
    const size_t hstep = (size_t)HALF * K * 2;
    const size_t tstep = 2 * hstep;
    const unsigned ldsw = (unsigned)wid * 1024u;
    const int aoff = lds_byte(wr * 64 + fr, fq * 8), boff = lds_byte(wc * 32 + fr, fq * 8);
#define PG8_SA(b, h) (((b) * 2 + (h)) * HTB)
#define PG8_SB(b, h) ((4 + (b) * 2 + (h)) * HTB)
#define PG8_STAGE(bufoff, gbase, voff) do { _Pragma("unroll") for (int _i = 0; _i < 2; ++_i) \
        __builtin_amdgcn_global_load_lds((const unsigned*)((const char*)(gbase) + (voff)[_i]), (PG8_LAS unsigned*)(lds + (bufoff) + ldsw + _i * 8192), 16, 0, 0); } while (0)
#define PG8_LDA(dst, b, h) do { _Pragma("unroll") for (int m = 0; m < 4; ++m) _Pragma("unroll") for (int k = 0; k < 2; ++k) dst[m][k] = *(const PG8_LAS bf16x8*)(lds + PG8_SA(b, h) + aoff + m * 2048 + k * 1024); } while (0)
#define PG8_LDB(dst, b, h) do { _Pragma("unroll") for (int n = 0; n < 2; ++n) _Pragma("unroll") for (int k = 0; k < 2; ++k) dst[n][k] = *(const PG8_LAS bf16x8*)(lds + PG8_SB(b, h) + boff + n * 2048 + k * 1024); } while (0)
#define PG8_MMA(ai, bj, At, Bt) do { __builtin_amdgcn_s_setprio(1); _Pragma("unroll") for (int m = 0; m < 4; ++m) _Pragma("unroll") for (int n = 0; n < 2; ++n) _Pragma("unroll") for (int k = 0; k < 2; ++k) \
        acc[ai][bj][m][n] = __builtin_amdgcn_mfma_f32_16x16x32_bf16(Bt[n][k], At[m][k], acc[ai][bj][m][n], 0, 0, 0); __builtin_amdgcn_s_setprio(0); } while (0)
#define PG8_WAIT_V(n) asm volatile("s_waitcnt vmcnt(" #n ")" ::: "memory")
#define PG8_WAIT_L(n) asm volatile("s_waitcnt lgkmcnt(" #n ")" ::: "memory")
#define PG8_BAR __builtin_amdgcn_s_barrier()
#define PG8_SCHED __builtin_amdgcn_sched_barrier(0)
    Unit cur, nxt; int ui = 0;
    if (!S.next(0, cur)) return;
    f32x4 acc[2][2][4][2];
#pragma unroll
    for (int a = 0; a < 2; ++a)
#pragma unroll
        for (int b = 0; b < 2; ++b)
#pragma unroll
            for (int m = 0; m < 4; ++m)
#pragma unroll
                for (int n = 0; n < 2; ++n) acc[a][b][m][n] = (f32x4){0.f, 0.f, 0.f, 0.f};
    bf16x8 At[4][2], B0[2][2], B1[2][2];
    const char* cA = (const char*)g.A + (size_t)cur.pm * tstep; const char* cB = (const char*)g.Bt + (size_t)cur.pn * tstep;
    S.a_ready(cur);
    if constexpr (SP2) {
        PG8_STAGE(PG8_SB(0, 0), cB, voffB); PG8_STAGE(PG8_SB(0, 1), cB + hstep, voffB); PG8_STAGE(PG8_SA(0, 0), cA, voffA); PG8_STAGE(PG8_SA(0, 1), cA + hstep, voffA);
        if (wr == 1) PG8_BAR;
        PG8_WAIT_V(2); PG8_BAR;
        PG8_STAGE(PG8_SB(1, 0), cB + kstep, voffB); PG8_STAGE(PG8_SA(1, 0), cA + kstep, voffA); PG8_STAGE(PG8_SB(1, 1), cB + hstep + kstep, voffB);
        PG8_WAIT_V(6); PG8_BAR;
    } else {
        PG8_STAGE(PG8_SB(0, 0), cB, voffB); PG8_STAGE(PG8_SA(0, 0), cA, voffA); PG8_STAGE(PG8_SB(0, 1), cB + hstep, voffB); PG8_STAGE(PG8_SA(0, 1), cA + hstep, voffA);
        if (wr == 1) PG8_BAR;
        PG8_WAIT_V(4); PG8_BAR;
        PG8_STAGE(PG8_SB(1, 0), cB + kstep, voffB); PG8_STAGE(PG8_SA(1, 0), cA + kstep, voffA); PG8_STAGE(PG8_SB(1, 1), cB + hstep + kstep, voffB);
        PG8_WAIT_V(6); PG8_BAR;
    }
    for (;;) {
        const bool has_next = S.next(ui + 1, nxt);
        const char* nA = has_next ? (const char*)g.A + (size_t)nxt.pm * tstep : cA; const char* nB = has_next ? (const char*)g.Bt + (size_t)nxt.pn * tstep : cB;
        for (int t = 0; t < nt; t += 2) {
            const bool last = (t == nt - 2);
            const char* a1 = cA + (size_t)(t + 1) * kstep;
            const char* a2 = last ? nA : cA + (size_t)(t + 2) * kstep; const char* b2 = last ? nB : cB + (size_t)(t + 2) * kstep;
            const char* a3 = a2 + kstep; const char* b3 = b2 + kstep;
            if (last && has_next) S.a_ready(nxt);
            if constexpr (SP2) {
            PG8_LDB(B0, 0, 0); PG8_LDB(B1, 0, 1); PG8_SCHED; PG8_LDA(At, 0, 0); PG8_STAGE(PG8_SA(1, 1), a1 + hstep, voffA);
            PG8_WAIT_V(8); PG8_WAIT_L(0); PG8_BAR; PG8_MMA(0, 0, At, B0); PG8_MMA(0, 1, At, B1); PG8_BAR; PG8_SCHED;
            PG8_LDA(At, 0, 1); PG8_STAGE(PG8_SB(0, 0), b2, voffB); PG8_STAGE(PG8_SB(0, 1), b2 + hstep, voffB); PG8_STAGE(PG8_SA(0, 0), a2, voffA);
            PG8_WAIT_V(8); PG8_WAIT_L(0); PG8_BAR; PG8_MMA(1, 0, At, B0); PG8_MMA(1, 1, At, B1); PG8_BAR; PG8_SCHED;
            PG8_LDB(B0, 1, 0); PG8_LDB(B1, 1, 1); PG8_SCHED; PG8_LDA(At, 1, 0); PG8_STAGE(PG8_SA(0, 1), a2 + hstep, voffA);
            PG8_WAIT_V(8); PG8_WAIT_L(0); PG8_BAR; PG8_MMA(0, 0, At, B0); PG8_MMA(0, 1, At, B1); PG8_BAR; PG8_SCHED;
            PG8_LDA(At, 1, 1); PG8_STAGE(PG8_SB(1, 0), b3, voffB); PG8_STAGE(PG8_SB(1, 1), b3 + hstep, voffB); PG8_STAGE(PG8_SA(1, 0), a3, voffA);
            PG8_WAIT_V(8); PG8_WAIT_L(0); PG8_BAR; PG8_MMA(1, 0, At, B0); PG8_MMA(1, 1, At, B1); PG8_BAR; PG8_SCHED;
            } else {
            PG8_LDB(B0, 0, 0); PG8_SCHED; PG8_LDA(At, 0, 0); PG8_STAGE(PG8_SA(1, 1), a1 + hstep, voffA);
            PG8_WAIT_L(8); PG8_BAR; PG8_WAIT_L(0); PG8_MMA(0, 0, At, B0); PG8_BAR; PG8_SCHED;
            PG8_LDB(B1, 0, 1); PG8_STAGE(PG8_SB(0, 0), b2, voffB);
            PG8_BAR; PG8_WAIT_L(0); PG8_MMA(0, 1, At, B1); PG8_BAR;
            PG8_LDA(At, 0, 1); PG8_STAGE(PG8_SA(0, 0), a2, voffA);
            PG8_BAR; PG8_WAIT_L(0); PG8_MMA(1, 0, At, B0); PG8_BAR; PG8_SCHED;
            PG8_STAGE(PG8_SB(0, 1), b2 + hstep, voffB);
            PG8_WAIT_V(6); PG8_BAR; PG8_MMA(1, 1, At, B1); PG8_BAR;
            PG8_LDB(B0, 1, 0); PG8_SCHED; PG8_LDA(At, 1, 0); PG8_STAGE(PG8_SA(0, 1), a2 + hstep, voffA);
            PG8_WAIT_L(8); PG8_BAR; PG8_WAIT_L(0); PG8_MMA(0, 0, At, B0); PG8_BAR; PG8_SCHED;
            PG8_LDB(B1, 1, 1); PG8_STAGE(PG8_SB(1, 0), b3, voffB);
            PG8_BAR; PG8_WAIT_L(0); PG8_MMA(0, 1, At, B1); PG8_BAR;
            PG8_LDA(At, 1, 1); PG8_STAGE(PG8_SA(1, 0), a3, voffA);
            PG8_BAR; PG8_WAIT_L(0); PG8_MMA(1, 0, At, B0); PG8_BAR; PG8_SCHED;
            PG8_STAGE(PG8_SB(1, 1), b3 + hstep, voffB);
            PG8_WAIT_V(6); PG8_BAR; PG8_MMA(1, 1, At, B1); PG8_BAR;
            }
        }
        if constexpr (ALIGN_EPI) { if (wr == 0) PG8_BAR; }
        if constexpr (!Epi::AFTER_DRAIN) { E(acc, cur, wr, wc, fr, fq); S.done(cur); }
        if (!has_next) break;
#pragma unroll
        for (int a = 0; a < 2; ++a)
#pragma unroll
            for (int b = 0; b < 2; ++b)
#pragma unroll
                for (int m = 0; m < 4; ++m)
#pragma unroll
                    for (int n = 0; n < 2; ++n) acc[a][b][m][n] = (f32x4){0.f, 0.f, 0.f, 0.f};
        cur = nxt; cA = nA; cB = nB; ++ui;
        if constexpr (ALIGN_EPI) { if (wr == 1) PG8_BAR; }
    }
    PG8_WAIT_V(0);
    if constexpr (!ALIGN_EPI) { if (wr == 0) PG8_BAR; }
    PG8_BAR;
    if constexpr (Epi::AFTER_DRAIN) { E.fused(acc, cur, wr, wc, fr, fq, lds, wid, lane); S.done(cur); }
#undef PG8_SA
#undef PG8_SB
#undef PG8_STAGE
#undef PG8_LDA
#undef PG8_LDB
#undef PG8_MMA
#undef PG8_WAIT_V
#undef PG8_WAIT_L
#undef PG8_BAR
#undef PG8_SCHED
}
}
#define GAS __attribute__((address_space(1)))
#define LAS __attribute__((address_space(3)))
typedef unsigned short bf16;
typedef unsigned v4u __attribute__((ext_vector_type(4)));
typedef unsigned v2u __attribute__((ext_vector_type(2)));
typedef float f32x4 __attribute__((ext_vector_type(4)));
typedef float f32x2 __attribute__((ext_vector_type(2)));
typedef float f32x16 __attribute__((ext_vector_type(16)));
typedef short bf16x8 __attribute__((ext_vector_type(8)));
typedef short s16x4 __attribute__((ext_vector_type(4)));
typedef GAS unsigned gu32;
#define LDS_WAIT() asm volatile("s_waitcnt lgkmcnt(0)" ::: "memory")
#define VM_WAIT() asm volatile("s_waitcnt vmcnt(0)" ::: "memory")
__device__ __forceinline__ unsigned f2bf(float f) { unsigned u = __builtin_bit_cast(unsigned, f); return (u + 0x7fffu + ((u >> 16) & 1u)) >> 16; }
__device__ __forceinline__ unsigned pk2(float lo, float hi) { return f2bf(lo) | (f2bf(hi) << 16); }
__device__ __forceinline__ float bflo(unsigned w) { return __builtin_bit_cast(float, w << 16); }
__device__ __forceinline__ float bfhi(unsigned w) { return __builtin_bit_cast(float, w & 0xffff0000u); }
#define XB_TMO      128
#define XB_XCNT(j)  (256  + 64 * (j))
#define XB_XSUB(j)  (1280 + 64 * (j))
#define XB_XGEN(j)  (2304 + 64 * (j))
#define XB_TOP      3328
#define XB_TOPGEN   3392
#define XCD_BAR_WORDS 3456
#define XB_SPIN_CAP (1u << 18)

__device__ __forceinline__ unsigned xb_ld(unsigned* p)              { return __hip_atomic_load(p, __ATOMIC_RELAXED, __HIP_MEMORY_SCOPE_AGENT); }
__device__ __forceinline__ unsigned xb_add(unsigned* p, unsigned v) { return __hip_atomic_fetch_add(p, v, __ATOMIC_RELAXED, __HIP_MEMORY_SCOPE_AGENT); }
__device__ __forceinline__ unsigned xb_xcc_id() { return (unsigned)__builtin_amdgcn_s_getreg((3 << 11) | 20) & 0xFu; }
#define XB_SPIN(cond, bar) do { unsigned _sp = 0; while (cond) { __builtin_amdgcn_s_sleep(1); \
    if ((++_sp & 255u) == 0u) { if (xb_ld(&(bar)[XB_TMO])) break; if (_sp > XB_SPIN_CAP) { atomicAdd(&(bar)[XB_TMO], 1u); break; } } } } while (0)

struct XcdBarrier {
    unsigned* bar; unsigned x;
    volatile LAS unsigned* st;
};

__device__ __forceinline__ XcdBarrier xcd_barrier_post(unsigned* bar, volatile LAS unsigned* st) {
    XcdBarrier b; b.bar = bar; b.x = xb_xcc_id(); b.st = st;
    if (threadIdx.x == 0) (void)xb_add(&bar[XB_XCNT(b.x)], 1u);
    return b;
}
__device__ __forceinline__ void xcd_barrier_complete(unsigned* bar, unsigned x, unsigned& nloc, unsigned& nx) {
    const unsigned G = gridDim.x * gridDim.y * gridDim.z;
    unsigned sum, cnt, mine, sp = 0u;
    for (;;) {
        sum = 0u; cnt = 0u; mine = 0u;
#pragma unroll
        for (unsigned j = 0; j < 16; ++j) { const unsigned c = xb_ld(&bar[XB_XCNT(j)]); sum += c; cnt += (c > 0u) ? 1u : 0u; mine = (j == x) ? c : mine; }
        if (sum == G) break;
        __builtin_amdgcn_s_sleep(1);
        if ((++sp & 255u) == 0u) { if (xb_ld(&bar[XB_TMO])) break; if (sp > XB_SPIN_CAP) { atomicAdd(&bar[XB_TMO], 1u); break; } }
    }
    nloc = mine > 0u ? mine : 1u; nx = cnt > 0u ? cnt : 1u;
}

__device__ __forceinline__ void xcd_barrier(const XcdBarrier& b) {
    asm volatile("s_waitcnt vmcnt(0)" ::: "memory");
    __syncthreads();
    if (threadIdx.x == 0) {
        unsigned* bar = b.bar;
        __builtin_amdgcn_s_waitcnt(0);
        unsigned nloc = b.st[0], nx = b.st[1];
        if (nloc == 0u) { xcd_barrier_complete(bar, b.x, nloc, nx); b.st[0] = nloc; b.st[1] = nx; }
        const unsigned old = xb_add(&bar[XB_XSUB(b.x)], 1u);
        const unsigned gen = old / nloc;
        if (old + 1u == (gen + 1u) * nloc) {
            __builtin_amdgcn_fence(__ATOMIC_RELEASE, "agent");
            asm volatile("s_waitcnt vmcnt(0)" ::: "memory");
            const unsigned og = xb_add(&bar[XB_TOP], 1u);
            const unsigned tg = og / nx;
            if (og + 1u == (tg + 1u) * nx) xb_add(&bar[XB_TOPGEN], 1u);
            else XB_SPIN(xb_ld(&bar[XB_TOPGEN]) == tg, bar);
            __builtin_amdgcn_fence(__ATOMIC_ACQUIRE, "agent");
            xb_add(&bar[XB_XGEN(b.x)], 1u);
            asm volatile("s_waitcnt vmcnt(0)" ::: "memory");
        } else {
            XB_SPIN(xb_ld(&bar[XB_XGEN(b.x)]) == gen, bar);
            __builtin_amdgcn_fence(__ATOMIC_ACQUIRE, "agent");
            asm volatile("s_waitcnt vmcnt(0)" ::: "memory");
        }
    }
    __syncthreads();
}
constexpr size_t MiB = 1u << 20;
constexpr size_t WS_CTL = 0, CTL_ZERO_BYTES = 1 * MiB;
constexpr size_t WS_WIN = 2 * MiB;
constexpr size_t WS_WOUT = WS_WIN + 16 * MiB;
constexpr size_t WS_WUP = WS_WOUT + 8 * MiB;
constexpr size_t WS_WDN = WS_WUP + 44 * MiB;
constexpr size_t WS_WDQ0 = WS_WDN + 22 * MiB;
constexpr size_t WS_WDQ1 = WS_WDQ0 + 2 * MiB;
constexpr size_t WS_WUQ = WS_WDQ1 + 1 * MiB;
constexpr size_t WS_WKV = WS_WUQ + 3 * MiB;
constexpr size_t WS_WUKN = WS_WKV + 1 * MiB;
constexpr size_t WS_WO = WS_WUKN + 1 * MiB;
constexpr size_t WS_ROPE = WS_WO + 4 * MiB;
constexpr size_t WS_X = WS_ROPE + 1 * MiB;
constexpr size_t WS_XB = WS_X + 64 * MiB;
constexpr size_t WS_RSTD = WS_XB + 32 * MiB;
constexpr size_t WS_U = WS_RSTD + 1 * MiB;
constexpr size_t WS_V = WS_U + 64 * MiB;
constexpr size_t WS_VSS = WS_V + 64 * MiB;
constexpr size_t WS_G2 = WS_VSS + 2 * MiB;
constexpr size_t WS_MO = WS_G2 + 64 * MiB;
constexpr size_t WS_MSS = WS_MO + 64 * MiB;
constexpr size_t WS_AB = WS_MSS + 1 * MiB;
constexpr size_t WS_GU = WS_AB + 176 * MiB;
constexpr size_t WS_CQ = WS_GU + 88 * MiB;
constexpr size_t WS_CQSS = WS_CQ + 16 * MiB;
constexpr size_t WS_KVR = WS_CQSS + 1 * MiB;
constexpr size_t WS_Q = WS_KVR + 20 * MiB;
constexpr size_t WS_CKVB = WS_Q + 48 * MiB;
constexpr size_t WS_KRB = WS_CKVB + 8 * MiB;
constexpr size_t WS_KN = WS_KRB + 2 * MiB;
constexpr size_t WS_VT = WS_KN + 32 * MiB;
constexpr size_t WS_OB = WS_VT + 32 * MiB;
constexpr size_t WS_FAST_END = WS_OB + 32 * MiB;
constexpr size_t WS_NAIVE = 1024 * MiB;
static_assert(WS_FAST_END <= WS_NAIVE, "ws map");
constexpr int CW_TMO = 0, CW_CODE = 1, CW_BAR = 4096;
constexpr int RING_OFF = 0, RING_BYTES = 131072;
constexpr int LDSCTL_OFF = RING_BYTES, MISC_OFF = LDSCTL_OFF + 320;
constexpr int LDS_BYTES = 147456;
constexpr int NWAVES = 8;
constexpr float LOG2E = 1.4426950408889634f;

struct Frame { LAS unsigned char* lds; volatile LAS unsigned* MISC; gu32* ctl; int tid, lane, wave, vcu, G; };
struct Args {
    const float *x_prompt, *x_sample, *cache_ckv, *cache_kr, *state_conv; const int* page_table;
    const float *pre_mix_g, *post_mix_g, *pre_ffn_g, *post_ffn_g, *w_in_a, *sgu_g, *w_s, *b_s, *w_out_a, *kv_in_g, *w_dkv, *kv_g, *w_uk, *w_uv, *w_dq, *q_g, *w_uq, *w_o, *w_up, *conv_w, *conv_b, *w_down;
    float* out; unsigned char* ws; int ph_lo, ph_hi;
};
__device__ __forceinline__ float wave_sum(float v) {
#pragma unroll
    for (int o = 1; o < 64; o <<= 1) v += __shfl_xor(v, o);
    return v;
}
__device__ __forceinline__ void p0_transpose_item(const float* W, int K, int N, bf16* WT, int row_off, const float* kscale, float cscale, int mode, LAS float* scr, int item, int lane) {
    const int nblk = N / 32, kb = item / nblk, nb = item % nblk, k0 = 64 * kb, n0 = 32 * nb;
#pragma unroll 8
    for (int i = 0; i < 32; ++i) { const int kk = 2 * i + (lane >> 5); const float sc = (kscale ? kscale[k0 + kk] : 1.0f) * cscale; scr[kk * 33 + (lane & 31)] = W[(size_t)(k0 + kk) * N + n0 + (lane & 31)] * sc; }
    LDS_WAIT(); asm volatile("" ::: "memory");
    const int c = lane & 7;
#pragma unroll
    for (int j = 0; j < 4; ++j) { const int n = (lane >> 3) + 8 * j; const LAS float* s = scr + (8 * c) * 33 + n;
        v4u o; o.x = pk2(s[0 * 33], s[1 * 33]); o.y = pk2(s[2 * 33], s[3 * 33]); o.z = pk2(s[4 * 33], s[5 * 33]); o.w = pk2(s[6 * 33], s[7 * 33]);
        int dr = n0 + n;
        if (mode == 2) { const int h = dr / 192, cin = dr % 192; if (cin >= 128) { const int i = cin - 128; dr = h * 192 + 128 + 2 * (i & 31) + (i >> 5); } }
        *(GAS v4u*)(WT + (size_t)(row_off + dr) * K + k0 + 8 * c) = o; }
    LDS_WAIT(); asm volatile("" ::: "memory");
}
__device__ __forceinline__ void p0_prologue(Frame& F, const Args& A) {
    unsigned char* ws = A.ws;
    LAS float* scr = (LAS float*)(F.lds + RING_OFF + F.wave * 16384);
    const int gw = F.vcu * NWAVES + F.wave, NGW = F.G * NWAVES;
    constexpr int I_IN = 16 * 128, I_OUT = 32 * 32, I_UP = 16 * 176, I_DN = 44 * 32, I_DQ = 16 * 16, I_DKV = 16 * 10, I_UQ = 8 * 48, I_KV = 4 * 32, I_O = 16 * 32;
    constexpr int NITEMS = 2 * I_IN + 2 * I_OUT + 4 * I_UP + 4 * I_DN + 2 * I_DQ + I_DKV + 2 * I_UQ + 2 * I_KV + 2 * I_O;
    for (int it = gw; it < NITEMS; it += NGW) {
        int r = it;
        if (r < 2 * I_IN) { const int l = r / I_IN; p0_transpose_item(A.w_in_a + (size_t)l * 1024 * 4096, 1024, 4096, (bf16*)(ws + WS_WIN) + (size_t)l * 4096 * 1024, 0, A.pre_mix_g + l * 1024, 1.0f, 0, scr, r % I_IN, F.lane); continue; } r -= 2 * I_IN;
        if (r < 2 * I_OUT) { const int l = r / I_OUT; p0_transpose_item(A.w_out_a + (size_t)l * 2048 * 1024, 2048, 1024, (bf16*)(ws + WS_WOUT) + (size_t)l * 1024 * 2048, 0, nullptr, 1.0f, 0, scr, r % I_OUT, F.lane); continue; } r -= 2 * I_OUT;
        if (r < 4 * I_UP) { const int l = r / I_UP; p0_transpose_item(A.w_up + (size_t)l * 1024 * 5632, 1024, 5632, (bf16*)(ws + WS_WUP) + (size_t)l * 5632 * 1024, 0, A.pre_ffn_g + l * 1024, 1.0f, 0, scr, r % I_UP, F.lane); continue; } r -= 4 * I_UP;
        if (r < 4 * I_DN) { const int l = r / I_DN; p0_transpose_item(A.w_down + (size_t)l * 2816 * 1024, 2816, 1024, (bf16*)(ws + WS_WDN) + (size_t)l * 1024 * 2816, 0, nullptr, 1.0f, 0, scr, r % I_DN, F.lane); continue; } r -= 4 * I_DN;
        if (r < 2 * I_DQ) { const int j = r / I_DQ; p0_transpose_item(A.w_dq + (size_t)j * 1024 * 512, 1024, 512, (bf16*)(ws + (j ? WS_WDQ1 : WS_WDQ0)), 0, A.pre_mix_g + (2 + j) * 1024, 1.0f, 0, scr, r % I_DQ, F.lane); continue; } r -= 2 * I_DQ;
        if (r < I_DKV) { p0_transpose_item(A.w_dkv, 1024, 320, (bf16*)(ws + WS_WDQ0), 512, A.kv_in_g, 1.0f, 0, scr, r, F.lane); continue; } r -= I_DKV;
        if (r < 2 * I_UQ) { const int j = r / I_UQ; p0_transpose_item(A.w_uq + (size_t)j * 512 * 1536, 512, 1536, (bf16*)(ws + WS_WUQ) + (size_t)j * 1536 * 512, 0, A.q_g + j * 512, 0.07216878364870322f * LOG2E, 2, scr, r % I_UQ, F.lane); continue; } r -= 2 * I_UQ;
        if (r < 2 * I_KV) { const int j = r / I_KV; p0_transpose_item(j ? A.w_uv : A.w_uk, 256, 1024, (bf16*)(ws + WS_WKV), j * 1024, nullptr, 1.0f, 0, scr, r % I_KV, F.lane); continue; } r -= 2 * I_KV;
        { const int j = r / I_O; p0_transpose_item(A.w_o + (size_t)j * 1024 * 1024, 1024, 1024, (bf16*)(ws + WS_WO) + (size_t)j * 1024 * 1024, 0, nullptr, 1.0f, 0, scr, r % I_O, F.lane); }
    }
    { const int gt = F.vcu * 512 + F.tid, NT = F.G * 512; GAS v4u* z = (GAS v4u*)(ws + WS_WDQ0 + (size_t)832 * 1024 * 2);
      for (int i = gt; i < 192 * 1024 * 2 / 16; i += NT) z[i] = (v4u){0u, 0u, 0u, 0u}; }
    { const int gt = F.vcu * 512 + F.tid, NT = F.G * 512; GAS unsigned* o = (GAS unsigned*)(ws + WS_WUKN);
      for (int i = gt; i < 256 * 1024 / 2; i += NT) o[i] = pk2(A.w_uk[2 * i], A.w_uk[2 * i + 1]); }
    { const int gt = F.vcu * 512 + F.tid, NT = F.G * 512; GAS float* tab = (GAS float*)(ws + WS_ROPE);
      for (int i = gt; i < 2049 * 32; i += NT) { const int p = i >> 5, k = i & 31; const int pos = p == 2048 ? 8192 : p;
          const float inv = 1.0f / powf(10000.0f, (float)k / 32.0f); const float ang = (float)pos * inv; float sn, cs; sincosf(ang, &sn, &cs); tab[2 * i] = cs; tab[2 * i + 1] = sn; } }
    { GAS float* X = (GAS float*)(ws + WS_X); GAS float* RS = (GAS float*)(ws + WS_RSTD);
      for (int m = gw; m < MP; m += NGW) {
          const GAS f32x4* xr = (const GAS f32x4*)(A.x_prompt + (size_t)m * 1024) + F.lane; GAS f32x4* xo = (GAS f32x4*)(X + (size_t)m * 1024) + F.lane;
          GAS v2u* xb = (GAS v2u*)(ws + WS_XB + (size_t)m * 2048) + F.lane; float s = 0.f;
#pragma unroll
          for (int j = 0; j < 4; ++j) { const f32x4 v = xr[64 * j]; xo[64 * j] = v; s += (v.x * v.x + v.y * v.y) + (v.z * v.z + v.w * v.w); xb[64 * j] = (v2u){pk2(v.x, v.y), pk2(v.z, v.w)}; }
          s = wave_sum(s); if (F.lane == 0) RS[m] = rsqrtf(s * (1.0f / 1024.0f) + EPS); } }
}
__device__ __forceinline__ void thin_post(Frame& F, const float* MO, const float* SS, const float* gain, float* X, bf16* XB, float* RSTD, float* Y) {
    const int gw = F.vcu * NWAVES + F.wave, NGW = F.G * NWAVES;
    for (int m = gw; m < MP; m += NGW) {
        float ss = SS[(size_t)m * 16 + (F.lane & 15)]; ss += __shfl_xor(ss, 1); ss += __shfl_xor(ss, 2); ss += __shfl_xor(ss, 4); ss += __shfl_xor(ss, 8);
        const float rm = rsqrtf(ss * (1.0f / 1024.0f) + EPS);
        const GAS f32x4* mr = (const GAS f32x4*)(MO + (size_t)m * 1024) + F.lane; const GAS f32x4* gr = (const GAS f32x4*)gain + F.lane; GAS f32x4* xr = (GAS f32x4*)(X + (size_t)m * 1024) + F.lane;
        GAS v2u* xb = (GAS v2u*)(XB + (size_t)m * 1024) + F.lane; float s = 0.f;
#pragma unroll
        for (int j = 0; j < 4; ++j) { const f32x4 mv = mr[64 * j], g = gr[64 * j]; f32x4 x = xr[64 * j]; x = x + mv * rm * g; xr[64 * j] = x; if (Y) ((GAS f32x4*)(Y + (size_t)m * 1024) + F.lane)[64 * j] = x;
            s += (x.x * x.x + x.y * x.y) + (x.z * x.z + x.w * x.w); xb[64 * j] = (v2u){pk2(x.x, x.y), pk2(x.z, x.w)}; }
        s = wave_sum(s); if (F.lane == 0) RSTD[m] = rsqrtf(s * (1.0f / 1024.0f) + EPS);
    }
}
typedef short v4i16_t __attribute__((__vector_size__(4 * sizeof(short))));
__device__ __forceinline__ s16x4 tr_read(LAS unsigned char* p) { return __builtin_bit_cast(s16x4, __builtin_amdgcn_ds_read_tr16_b64_v4i16((LAS v4i16_t*)p)); }
__device__ __forceinline__ void sgu_phase(Frame& F, const bf16* U, const bf16* V, const float* VSS, const float* w_s, const float* b_s, const float* sgu_g, bf16* G2) {
    constexpr int WSM_OFF = 0, WSM_LD = 272, VT_OFF = 34816, VT_LD = 528, RS_OFF = 102400;
    LAS unsigned char* lds = F.lds; LAS float* RS = (LAS float*)(lds + RS_OFF);
    const int lane = F.lane, w = F.wave, q = lane >> 4, i16 = lane & 15;
    for (int unit = F.vcu; unit < 1024; unit += F.G) {
        const int chunk = unit >> 3, g = unit & 7, row0 = chunk * 128;
        __syncthreads();
        if (F.tid < 128) { const GAS f32x4* p = (const GAS f32x4*)(VSS + (size_t)(row0 + F.tid) * 32); float s = 0.f;
#pragma unroll
            for (int k = 0; k < 8; ++k) { const f32x4 v = p[k]; s += (v.x + v.y) + (v.z + v.w); }
            RS[F.tid] = rsqrtf(s * (1.0f / 2048.0f) + EPS); }
        __syncthreads();
#pragma unroll
        for (int k = 0; k < 8; ++k) { const int idx = F.tid + 512 * k, t = idx >> 5, s4 = (idx & 31) * 4; const f32x4 wv = *(const GAS f32x4*)(w_s + ((size_t)g * 128 + t) * 128 + s4);
            const float a0 = s4 + 0 <= t ? wv.x * RS[s4 + 0] : 0.f, a1 = s4 + 1 <= t ? wv.y * RS[s4 + 1] : 0.f, a2 = s4 + 2 <= t ? wv.z * RS[s4 + 2] : 0.f, a3 = s4 + 3 <= t ? wv.w * RS[s4 + 3] : 0.f;
            *(LAS v2u*)(lds + WSM_OFF + t * WSM_LD + s4 * 2) = (v2u){pk2(a0, a1), pk2(a2, a3)}; }
#pragma unroll
        for (int k = 0; k < 8; ++k) { const int idx = F.tid + 512 * k, s = idx >> 5, ch = idx & 31; const v4u vv = *(const GAS v4u*)(V + (size_t)(row0 + s) * 2048 + g * 256 + ch * 8);
            *(LAS v4u*)(lds + VT_OFF + s * VT_LD + ch * 16) = vv; }
        __syncthreads();
        f32x4 acc[8][2];
#pragma unroll
        for (int tb = 0; tb < 8; ++tb) { acc[tb][0] = (f32x4){0.f, 0.f, 0.f, 0.f}; acc[tb][1] = (f32x4){0.f, 0.f, 0.f, 0.f}; }
#pragma unroll
        for (int ks = 0; ks < 4; ++ks) {
            bf16x8 xf[2];
#pragma unroll
            for (int dbi = 0; dbi < 2; ++dbi) { LAS unsigned char* p = lds + VT_OFF + (32 * ks + 8 * q + (i16 >> 2)) * VT_LD + (16 * (2 * w + dbi) + 4 * (i16 & 3)) * 2;
                const s16x4 lo = tr_read(p), hi = tr_read(p + 4 * VT_LD); xf[dbi] = (bf16x8){lo[0], lo[1], lo[2], lo[3], hi[0], hi[1], hi[2], hi[3]}; }
#pragma unroll
            for (int tb = 2 * ks; tb < 8; ++tb) { const bf16x8 yf = *(const LAS bf16x8*)(lds + WSM_OFF + (16 * tb + i16) * WSM_LD + (32 * ks + 8 * q) * 2);
                acc[tb][0] = __builtin_amdgcn_mfma_f32_16x16x32_bf16(xf[0], yf, acc[tb][0], 0, 0, 0);
                acc[tb][1] = __builtin_amdgcn_mfma_f32_16x16x32_bf16(xf[1], yf, acc[tb][1], 0, 0, 0); }
        }
#pragma unroll
        for (int dbi = 0; dbi < 2; ++dbi) { const int d = g * 256 + 16 * (2 * w + dbi) + 4 * q; const f32x4 gg = *(const GAS f32x4*)(sgu_g + d);
#pragma unroll
            for (int tb = 0; tb < 8; ++tb) { const int t = 16 * tb + i16; const float bb = b_s[g * 128 + t]; const size_t off = (size_t)(row0 + t) * 2048 + d;
                const v2u uu = *(const GAS v2u*)(U + off); const f32x4 a = acc[tb][dbi];
                const float o0 = bflo(uu.x) * (a[0] * gg[0] + bb), o1 = bfhi(uu.x) * (a[1] * gg[1] + bb), o2 = bflo(uu.y) * (a[2] * gg[2] + bb), o3 = bfhi(uu.y) * (a[3] * gg[3] + bb);
                *(GAS v2u*)(G2 + off) = (v2u){pk2(o0, o1), pk2(o2, o3)}; } }
    }
    __syncthreads();
}
__device__ __forceinline__ float gelu_tanh_fast(float x) { const float u = 0.7978845608028654f * (x + 0.044715f * x * x * x); const float e = __builtin_amdgcn_exp2f(-2.0f * LOG2E * u); return x * __builtin_amdgcn_rcpf(1.0f + e); }
__device__ __forceinline__ void unpack8(const v4u v, float (&f)[8]) { f[0] = bflo(v.x); f[1] = bfhi(v.x); f[2] = bflo(v.y); f[3] = bfhi(v.y); f[4] = bflo(v.z); f[5] = bfhi(v.z); f[6] = bflo(v.w); f[7] = bfhi(v.w); }
__device__ __forceinline__ void conv_phase(Frame& F, const bf16* AB, const float* cw, const float* cb, bf16* GU) {
    const int gt = F.vcu * 512 + F.tid, NT = F.G * 512;
    for (int item = gt; item < 1024 * 352; item += NT) {
        const int rb = item / 352, jc = item % 352, j0 = jc * 8, r0 = rb * 16;
        float wg[3][8], wu[3][8], bg[8], bu[8];
#pragma unroll
        for (int k = 0; k < 3; ++k)
#pragma unroll
            for (int e = 0; e < 8; ++e) { wg[k][e] = cw[k * 5632 + j0 + e]; wu[k][e] = cw[k * 5632 + 2816 + j0 + e]; }
#pragma unroll
        for (int e = 0; e < 8; ++e) { bg[e] = cb[j0 + e]; bu[e] = cb[2816 + j0 + e]; }
        float g2[8], g1[8], u2[8], u1[8];
        if ((r0 & 2047) != 0) {
            unpack8(*(const GAS v4u*)(AB + (size_t)(r0 - 2) * 5632 + j0), g2); unpack8(*(const GAS v4u*)(AB + (size_t)(r0 - 1) * 5632 + j0), g1);
            unpack8(*(const GAS v4u*)(AB + (size_t)(r0 - 2) * 5632 + 2816 + j0), u2); unpack8(*(const GAS v4u*)(AB + (size_t)(r0 - 1) * 5632 + 2816 + j0), u1);
        } else {
#pragma unroll
            for (int e = 0; e < 8; ++e) { g2[e] = 0.f; g1[e] = 0.f; u2[e] = 0.f; u1[e] = 0.f; }
        }
#pragma unroll 1
        for (int i = 0; i < 16; ++i) {
            float g0[8], u0[8], o[8];
            unpack8(*(const GAS v4u*)(AB + (size_t)(r0 + i) * 5632 + j0), g0); unpack8(*(const GAS v4u*)(AB + (size_t)(r0 + i) * 5632 + 2816 + j0), u0);
#pragma unroll
            for (int e = 0; e < 8; ++e) { const float cg = bg[e] + wg[0][e] * g2[e] + wg[1][e] * g1[e] + wg[2][e] * g0[e]; const float cu = bu[e] + wu[0][e] * u2[e] + wu[1][e] * u1[e] + wu[2][e] * u0[e];
                o[e] = gelu_tanh_fast(cg) * cu; g2[e] = g1[e]; g1[e] = g0[e]; u2[e] = u1[e]; u1[e] = u0[e]; }
            *(GAS v4u*)(GU + (size_t)(r0 + i) * 2816 + j0) = (v4u){pk2(o[0], o[1]), pk2(o[2], o[3]), pk2(o[4], o[5]), pk2(o[6], o[7])};
        }
    }
}
__device__ __forceinline__ void kvfinal_phase(Frame& F, const float* KVR, const float* kv_g, const float* rope, float* out_ckv, float* out_kr, bf16* CKVB, bf16* KRB) {
    const int gw = F.vcu * NWAVES + F.wave, NGW = F.G * NWAVES, lane = F.lane;
    for (int m = gw; m < MP; m += NGW) {
        const float* r = KVR + (size_t)m * 320;
        const f32x4 v = *(const GAS f32x4*)(r + 4 * lane); const f32x4 g = *(const GAS f32x4*)(kv_g + 4 * lane);
        float s = (v.x * v.x + v.y * v.y) + (v.z * v.z + v.w * v.w); s = wave_sum(s);
        const float rs = rsqrtf(s * (1.0f / 256.0f) + EPS);
        const f32x4 o = v * rs * g;
        *(GAS f32x4*)(out_ckv + (size_t)m * 256 + 4 * lane) = o;
        *(GAS v2u*)(CKVB + (size_t)m * 256 + 4 * lane) = (v2u){pk2(o.x, o.y), pk2(o.z, o.w)};
        if (lane < 32) { const float x1 = r[256 + lane], x2 = r[288 + lane]; const int pos = m & 2047; const f32x2 cs = *(const GAS f32x2*)(rope + ((size_t)pos * 32 + lane) * 2);
            const float o1 = x1 * cs.x - x2 * cs.y, o2 = x2 * cs.x + x1 * cs.y;
            out_kr[(size_t)m * 64 + lane] = o1; out_kr[(size_t)m * 64 + 32 + lane] = o2;
            *(GAS unsigned*)(KRB + (size_t)m * 64 + 2 * lane) = pk2(o1, o2); }
    }
}
constexpr int AT_KLD = 400, AT_VLD = 136, AT_VOFF = 25600, AT_STAGE = 43008;
__device__ __forceinline__ void attn_phase(Frame& F, const bf16* Q, const bf16* KN, const bf16* KRB, const bf16* VT, bf16* OB) {
    const int lane = F.lane, w = F.wave, tid = F.tid, r32 = lane & 31, hh = lane >> 5;
    LAS unsigned char* lds = F.lds;
    for (int p = F.vcu; p < 256; p += F.G) {
#pragma unroll 1
        for (int half = 0; half < 2; ++half) {
            const int bh = p >> 2, sidx = p & 3, qb = half ? 7 - sidx : sidx, b = bh >> 3, h = bh & 7;
            const int q0 = 256 * qb + 32 * w; const int nt = 4 * (qb + 1);
            const GAS unsigned char* q_t = (const GAS unsigned char*)(Q + ((size_t)b * 2048 + 256 * qb) * 1536 + h * 192);
            const unsigned qoff = (unsigned)(32 * w + r32) * 3072u + (unsigned)hh * 16u;
            bf16x8 qf[12];
#pragma unroll
            for (int ks = 0; ks < 12; ++ks) qf[ks] = *(const GAS bf16x8*)(q_t + qoff + 32 * ks);
            v4u kreg[3], vreg[2];
            const GAS unsigned char* kn_t = (const GAS unsigned char*)(KN + ((size_t)b * 2048) * 1024 + h * 128);
            const GAS unsigned char* kr_t = (const GAS unsigned char*)(KRB + ((size_t)b * 2048) * 64);
            const GAS unsigned char* vt_t = (const GAS unsigned char*)(VT + ((size_t)h * 128) * MP + (size_t)b * 2048);
#define AT_LOAD(j) do { \
                _Pragma("unroll") for (int i = 0; i < 2; ++i) { const unsigned c = tid + 512 * i; kreg[i] = *(const GAS v4u*)(kn_t + (size_t)(j) * (64 * 2048) + ((c >> 4) * 2048u + (c & 15u) * 16u)); } \
                kreg[2] = *(const GAS v4u*)(kr_t + (size_t)(j) * (64 * 128) + (((unsigned)tid >> 3) * 128u + ((unsigned)tid & 7u) * 16u)); \
                _Pragma("unroll") for (int i = 0; i < 2; ++i) { const unsigned c = tid + 512 * i; vreg[i] = *(const GAS v4u*)(vt_t + (size_t)(j) * 128 + ((c >> 3) * (unsigned)(MP * 2) + (c & 7u) * 16u)); } } while (0)
#define AT_STORE(st) do { \
                _Pragma("unroll") for (int i = 0; i < 2; ++i) { const unsigned c = tid + 512 * i; *(LAS v4u*)((st) + (c >> 4) * AT_KLD + (c & 15u) * 16u) = kreg[i]; } \
                *(LAS v4u*)((st) + ((unsigned)tid >> 3) * AT_KLD + 256 + ((unsigned)tid & 7u) * 16u) = kreg[2]; \
                _Pragma("unroll") for (int i = 0; i < 2; ++i) { const unsigned c = tid + 512 * i; LAS unsigned char* vp_ = (st) + AT_VOFF + (c >> 3) * AT_VLD + (c & 7u) * 16u; \
                    *(LAS v2u*)vp_ = (v2u){vreg[i].x, vreg[i].y}; *(LAS v2u*)(vp_ + 8) = (v2u){vreg[i].z, vreg[i].w}; } } while (0)
            AT_LOAD(0);
            float m_run = -1.0e30f, l_run = 0.f;
            f32x16 O[4];
#pragma unroll
            for (int db = 0; db < 4; ++db)
#pragma unroll
                for (int e = 0; e < 16; ++e) O[db][e] = 0.f;
            __syncthreads();
#pragma unroll 1
            for (int j = 0; j < nt; ++j) {
                LAS unsigned char* st = lds + (j & 1) * AT_STAGE;
                AT_STORE(st);
                __syncthreads();
                if (j + 1 < nt) AT_LOAD(j + 1);
                if (64 * j > q0 + 31) continue;
                f32x16 S[2];
#pragma unroll
                for (int kb = 0; kb < 2; ++kb) {
#pragma unroll
                    for (int e = 0; e < 16; ++e) S[kb][e] = 0.f;
#pragma unroll
                    for (int ks = 0; ks < 12; ++ks) { const bf16x8 kf = *(const LAS bf16x8*)(st + (32 * kb + r32) * AT_KLD + (16 * ks + 8 * hh) * 2);
                        S[kb] = __builtin_amdgcn_mfma_f32_32x32x16_bf16(kf, qf[ks], S[kb], 0, 0, 0);
                        if ((ks & 3) == 3) asm volatile("" ::: "memory"); }
                }
                if (64 * j + 63 > q0) {
                    const int qa = q0 + r32;
#pragma unroll
                    for (int kb = 0; kb < 2; ++kb)
#pragma unroll
                        for (int e = 0; e < 16; ++e) { const int ka = 64 * j + 32 * kb + (e & 3) + 8 * (e >> 2) + 4 * hh; if (ka > qa) S[kb][e] = -1.0e30f; }
                }
                float mx = S[0][0];
#pragma unroll
                for (int kb = 0; kb < 2; ++kb)
#pragma unroll
                    for (int e = 0; e < 16; ++e) mx = fmaxf(mx, S[kb][e]);
                mx = fmaxf(mx, __shfl_xor(mx, 32));
                const float m_new = fmaxf(m_run, mx); const float alpha = __builtin_amdgcn_exp2f(m_run - m_new); m_run = m_new;
                float rsum = 0.f;
#pragma unroll
                for (int kb = 0; kb < 2; ++kb)
#pragma unroll
                    for (int e = 0; e < 16; ++e) { const float pv = __builtin_amdgcn_exp2f(S[kb][e] - m_new); S[kb][e] = pv; rsum += pv; }
                rsum += __shfl_xor(rsum, 32);
                l_run = l_run * alpha + rsum;
#pragma unroll
                for (int db = 0; db < 4; ++db)
#pragma unroll
                    for (int e = 0; e < 16; ++e) O[db][e] *= alpha;
                bf16x8 pf[2][2];
#pragma unroll
                for (int kb = 0; kb < 2; ++kb)
#pragma unroll
                    for (int s = 0; s < 2; ++s) { const unsigned a0 = pg8::cvt_pk_bf16(S[kb][8 * s + 0], S[kb][8 * s + 1]), a1 = pg8::cvt_pk_bf16(S[kb][8 * s + 2], S[kb][8 * s + 3]),
                                                                 a2 = pg8::cvt_pk_bf16(S[kb][8 * s + 4], S[kb][8 * s + 5]), a3 = pg8::cvt_pk_bf16(S[kb][8 * s + 6], S[kb][8 * s + 7]);
                        pf[kb][s] = __builtin_bit_cast(bf16x8, (v4u){a0, a1, a2, a3}); }
#pragma unroll
                for (int db = 0; db < 4; ++db)
#pragma unroll
                    for (int kb = 0; kb < 2; ++kb)
#pragma unroll
                        for (int s = 0; s < 2; ++s) { LAS unsigned char* vp = st + AT_VOFF + (32 * db + r32) * AT_VLD + (32 * kb + 16 * s + 4 * hh) * 2;
                            const v2u lo = *(const LAS v2u*)vp, hi = *(const LAS v2u*)(vp + 16);
                            const bf16x8 vf = __builtin_bit_cast(bf16x8, (v4u){lo.x, lo.y, hi.x, hi.y});
                            O[db] = __builtin_amdgcn_mfma_f32_32x32x16_bf16(vf, pf[kb][s], O[db], 0, 0, 0); if (kb == 1 && s == 1) asm volatile("" ::: "memory"); }
            }
            const float inv = 1.0f / l_run;
            GAS unsigned char* o_t = (GAS unsigned char*)(OB + ((size_t)b * 2048 + 256 * qb) * 1024 + h * 128); const unsigned ooff = (unsigned)(32 * w + r32) * 2048u;
#pragma unroll
            for (int db = 0; db < 4; ++db)
#pragma unroll
                for (int g4 = 0; g4 < 4; ++g4) { const int d = 32 * db + 8 * g4 + 4 * hh;
                    *(GAS v2u*)(o_t + ooff + 2 * d) = (v2u){pk2(O[db][4 * g4 + 0] * inv, O[db][4 * g4 + 1] * inv), pk2(O[db][4 * g4 + 2] * inv, O[db][4 * g4 + 3] * inv)}; }
#undef AT_LOAD
#undef AT_STORE
        }
    }
    __syncthreads();
}
constexpr int NPH_A = 8;
constexpr int NPH_FAST = 1 + 2 * NPH_A + 10 + 9;
#define X ((float*)(ws + WS_X))
#define XB ((bf16*)(ws + WS_XB))
#define RSTD ((float*)(ws + WS_RSTD))
#define U ((bf16*)(ws + WS_U))
#define V ((bf16*)(ws + WS_V))
#define VSS ((float*)(ws + WS_VSS))
#define G2 ((bf16*)(ws + WS_G2))
#define MO ((float*)(ws + WS_MO))
#define MSS ((float*)(ws + WS_MSS))
#define AB ((bf16*)(ws + WS_AB))
#define GU ((bf16*)(ws + WS_GU))
#define CQ ((bf16*)(ws + WS_CQ))
#define CQSS ((float*)(ws + WS_CQSS))
#define KVR ((float*)(ws + WS_KVR))
#define Qb ((bf16*)(ws + WS_Q))
#define CKVB ((bf16*)(ws + WS_CKVB))
#define KRB ((bf16*)(ws + WS_KRB))
#define KN ((bf16*)(ws + WS_KN))
#define VT ((bf16*)(ws + WS_VT))
#define OB ((bf16*)(ws + WS_OB))
#define ROPE ((const float*)(ws + WS_ROPE))
#define y_prompt (A.out)
#define ckv_p (A.out + (size_t)MP * D_MODEL + (size_t)MS * D_MODEL)
#define kr_p (ckv_p + (size_t)MP * KV_LORA)
#define conv_p (kr_p + (size_t)MP * QK_ROPE)

#define PHASE_BEGIN if (ph >= lo && ph < hi) { ws = A.ws; asm volatile("" : "+s"(ws)); F.tid = threadIdx.x; asm volatile("" : "+v"(F.tid)); F.lane = F.tid & 63;
#define PHASE_END if (ph + 1 < hi) xcd_barrier(bar); } ++ph;
template <int LAYER> __device__ __forceinline__ void layer_phases(Frame& F, const Args& A, unsigned char*& ws, const XcdBarrier& bar, int& ph, const int lo, const int hi) {
    constexpr int layer = LAYER;
      if (layer < 2) {
        PHASE_BEGIN {
            pg8::Gemm g{XB, (const bf16*)(ws + WS_WIN) + (size_t)layer * 4096 * 1024, MP, 4096, 1024}; pg8::StaticOrder S; S.init(MP, 4096, F.G, (int)blockIdx.x);
            pg8::EpiZ E{U, V, RSTD, VSS};
            pg8::gemm_phase<pg8::EpiZ, pg8::StaticOrder, true, true>(F.lds + RING_OFF, g, S, E);
        } PHASE_END
        PHASE_BEGIN sgu_phase(F, U, V, VSS, A.w_s + (size_t)layer * 8 * 128 * 128, A.b_s + (size_t)layer * 8 * 128, A.sgu_g + (size_t)layer * 2048, G2); PHASE_END
      } else {
        const int j = layer - 2;
        PHASE_BEGIN {
            pg8::Gemm g{XB, (const bf16*)(ws + (j ? WS_WDQ1 : WS_WDQ0)), MP, j ? 512 : 1024, 1024}; pg8::StaticOrder S; S.init(MP, j ? 512 : 1024, F.G, (int)blockIdx.x);
            pg8::EpiDq E{CQ, RSTD, CQSS, KVR};
            pg8::gemm_phase<pg8::EpiDq, pg8::StaticOrder, true, true>(F.lds + RING_OFF, g, S, E);
        } PHASE_END
        PHASE_BEGIN {
            if (j == 0) kvfinal_phase(F, KVR, A.kv_g, ROPE, ckv_p, kr_p, CKVB, KRB);
            pg8::Gemm g{CQ, (const bf16*)(ws + WS_WUQ) + (size_t)j * 1536 * 512, MP, 1536, 512}; pg8::StaticOrder S; S.init(MP, 1536, F.G, (int)blockIdx.x);
            pg8::EpiQ E{Qb, CQSS, ROPE};
            pg8::gemm_phase<pg8::EpiQ, pg8::StaticOrder, true, true>(F.lds + RING_OFF, g, S, E);
        } PHASE_END
        if (j == 0) {
            PHASE_BEGIN {
                { pg8::Gemm g{CKVB, (const bf16*)(ws + WS_WKV), MP, 1024, 256}; pg8::StaticOrder S; S.init(MP, 1024, F.G, (int)blockIdx.x); pg8::EpiBf E{KN, 1024};
                  pg8::gemm_phase<pg8::EpiBf, pg8::StaticOrder, true, true>(F.lds + RING_OFF, g, S, E); }
                { pg8::Gemm g{(const bf16*)(ws + WS_WKV) + (size_t)1024 * 256, CKVB, 1024, MP, 256}; pg8::StaticOrder S; S.init(1024, MP, F.G, (int)blockIdx.x); pg8::EpiBf E{VT, MP};
                  pg8::gemm_phase<pg8::EpiBf, pg8::StaticOrder, true, true>(F.lds + RING_OFF, g, S, E); }
            } PHASE_END
        }
        PHASE_BEGIN attn_phase(F, Qb, KN, KRB, VT, OB); PHASE_END
      }
        PHASE_BEGIN {
            pg8::Gemm g{layer < 2 ? G2 : OB, layer < 2 ? (const bf16*)(ws + WS_WOUT) + (size_t)layer * 1024 * 2048 : (const bf16*)(ws + WS_WO) + (size_t)(layer - 2) * 1024 * 1024, MP, 1024, layer < 2 ? 2048 : 1024}; pg8::StaticOrder S; S.init(MP, 1024, F.G, (int)blockIdx.x);
            pg8::EpiF32SS E{MO, 1024, MSS, 16};
            pg8::gemm_phase<pg8::EpiF32SS, pg8::StaticOrder, true, true>(F.lds + RING_OFF, g, S, E);
        } PHASE_END
        PHASE_BEGIN thin_post(F, MO, MSS, A.post_mix_g + layer * 1024, X, XB, RSTD, nullptr); PHASE_END
        PHASE_BEGIN {
            pg8::Gemm g{XB, (const bf16*)(ws + WS_WUP) + (size_t)layer * 5632 * 1024, MP, 5632, 1024}; pg8::StaticOrder S; S.init(MP, 5632, F.G, (int)blockIdx.x);
            pg8::EpiUp E{AB, RSTD, conv_p + (size_t)layer * 8 * 2 * 5632};
            pg8::gemm_phase<pg8::EpiUp, pg8::StaticOrder, true, true>(F.lds + RING_OFF, g, S, E);
        } PHASE_END
        PHASE_BEGIN conv_phase(F, AB, A.conv_w + (size_t)layer * 3 * 5632, A.conv_b + (size_t)layer * 5632, GU); PHASE_END
        PHASE_BEGIN {
            pg8::Gemm g{GU, (const bf16*)(ws + WS_WDN) + (size_t)layer * 1024 * 2816, MP, 1024, 2816}; pg8::StaticOrder S; S.init(MP, 1024, F.G, (int)blockIdx.x);
            pg8::EpiF32SS E{MO, 1024, MSS, 16};
            pg8::gemm_phase<pg8::EpiF32SS, pg8::StaticOrder, true, true>(F.lds + RING_OFF, g, S, E);
        } PHASE_END
        PHASE_BEGIN thin_post(F, MO, MSS, A.post_ffn_g + layer * 1024, X, XB, RSTD, layer == 3 ? y_prompt : nullptr); PHASE_END
}
__global__ void __launch_bounds__(NWAVES * 64, 2) fwd(Args A) {
    extern __shared__ __attribute__((aligned(16))) unsigned char lds_raw[];
    Frame F;
    F.lds = (LAS unsigned char*)lds_raw;
    F.MISC = (volatile LAS unsigned*)(F.lds + MISC_OFF);
    F.tid = threadIdx.x; F.lane = F.tid & 63; F.wave = __builtin_amdgcn_readfirstlane(F.tid >> 6);
    F.G = gridDim.x; { const int bx = blockIdx.x; F.vcu = (F.G % 8 == 0) ? (bx % 8) * (F.G / 8) + bx / 8 : bx; }
    unsigned char* ws = A.ws;
    F.ctl = (gu32*)(ws + WS_CTL);
    for (int u = F.tid; u < (LDS_BYTES - LDSCTL_OFF) / 4; u += NWAVES * 64) ((LAS unsigned*)(F.lds + LDSCTL_OFF))[u] = 0u;
    __syncthreads();
    XcdBarrier bar = xcd_barrier_post((unsigned*)(F.ctl + CW_BAR), F.MISC + 8);
    const int lo = A.ph_lo, hi = A.ph_hi; int ph = 0;
    PHASE_BEGIN p0_prologue(F, A); PHASE_END
    layer_phases<0>(F, A, ws, bar, ph, lo, hi);
    layer_phases<1>(F, A, ws, bar, ph, lo, hi);
    layer_phases<2>(F, A, ws, bar, ph, lo, hi);
    layer_phases<3>(F, A, ws, bar, ph, lo, hi);
}
#undef PHASE_BEGIN
#undef PHASE_END
#undef X
#undef XB
#undef RSTD
#undef U
#undef V
#undef VSS
#undef G2
#undef MO
#undef MSS
#undef AB
#undef GU
#undef CQ
#undef CQSS
#undef KVR
#undef Qb
#undef CKVB
#undef KRB
#undef KN
#undef VT
#undef OB
#undef ROPE
#undef y_prompt
#undef ckv_p
#undef kr_p
#undef conv_p

struct Ptrs {
    const float *x_prompt, *x_sample, *cache_ckv, *cache_kr, *state_conv; const int* page_table;
    const float *pre_mix_g, *post_mix_g, *pre_ffn_g, *post_ffn_g, *w_in_a, *sgu_g, *w_s, *b_s, *w_out_a, *kv_in_g, *w_dkv, *kv_g, *w_uk, *w_uv, *w_dq, *q_g, *w_uq, *w_o, *w_up, *conv_w, *conv_b, *w_down;
};
static void gemm(hipStream_t st, bool tb, const float* A, int lda, const float* B, int ldb, float* C, int ldc, int M, int N, int K, int accum = 0) {
    dim3 grid(N / 64, M / 64);
    if (tb) hipLaunchKernelGGL(nk_gemm<true>, grid, dim3(256), 0, st, A, lda, B, ldb, C, ldc, M, N, K, accum);
    else hipLaunchKernelGGL(nk_gemm<false>, grid, dim3(256), 0, st, A, lda, B, ldb, C, ldc, M, N, K, accum);
}
struct Bufs { float *X, *H, *Z, *G2, *MO, *A, *GU, *KV, *CKV, *KR, *CQ, *Q, *QL, *QP, *OL, *O, *S, *Ss; };

static void run_group_naive(hipStream_t st, const Ptrs& P, Bufs W, const float* xin, int nb, int T, int pos0, bool sample, int first_layer,
                            float* y, float* out_ckv, float* out_kr, float* out_conv, float* out_chunkv) {
    const int M = nb * T;
    W.CKV = out_ckv; W.KR = out_kr;
    if (first_layer == 0) (void)hipMemcpyAsync(W.X, xin, (size_t)M * D_MODEL * 4, hipMemcpyDeviceToDevice, st);
    const float scale = 1.0f / sqrtf((float)(QK_NOPE + QK_ROPE));
    for (int layer = first_layer; layer < DEPTH; ++layer) {
        if (layer == N_A) {
            hipLaunchKernelGGL(nk_rmsnorm, dim3(M), dim3(256), 0, st, W.X, D_MODEL, P.kv_in_g, W.H, D_MODEL, D_MODEL);
            gemm(st, false, W.H, D_MODEL, P.w_dkv, 320, W.KV, 320, M, 320, D_MODEL);
            hipLaunchKernelGGL(nk_rmsnorm, dim3(M), dim3(256), 0, st, W.KV, 320, P.kv_g, W.CKV, KV_LORA, KV_LORA);
            hipLaunchKernelGGL(nk_rope, dim3(1024), dim3(256), 0, st, W.KV, 320, 256, 0, 1, W.KR, 64, 0, 0, M, T, pos0);
        }
        hipLaunchKernelGGL(nk_rmsnorm, dim3(M), dim3(256), 0, st, W.X, D_MODEL, P.pre_mix_g + layer * D_MODEL, W.H, D_MODEL, D_MODEL);
        if (layer < N_A) {
            gemm(st, false, W.H, D_MODEL, P.w_in_a + (size_t)layer * D_MODEL * 4096, 4096, W.Z, 4096, M, 4096, D_MODEL);
            hipLaunchKernelGGL(nk_gelu_exact, dim3(2048), dim3(256), 0, st, W.Z, (size_t)M * 4096);
            hipLaunchKernelGGL(nk_rmsnorm, dim3(M), dim3(256), 0, st, W.Z + 2048, 4096, P.sgu_g + layer * 2048, W.Z + 2048, 4096, 2048);
            if (sample) hipLaunchKernelGGL(nk_copy2d, dim3(256), dim3(256), 0, st, W.Z + 2048, 4096, out_chunkv + (size_t)layer * M * 2048, 2048, M, 2048);
            const int cl = T >= CHUNK ? CHUNK : T;
            hipLaunchKernelGGL(nk_sgu, dim3(M / cl, 8), dim3(256), 0, st, W.Z, P.w_s + (size_t)layer * 8 * CHUNK * CHUNK, P.b_s + (size_t)layer * 8 * CHUNK, W.G2, cl);
            gemm(st, false, W.G2, 2048, P.w_out_a + (size_t)layer * 2048 * D_MODEL, D_MODEL, W.MO, D_MODEL, M, D_MODEL, 2048);
        } else {
            const int j = layer - N_A;
            gemm(st, false, W.H, D_MODEL, P.w_dq + (size_t)j * D_MODEL * Q_LORA, Q_LORA, W.Q  , Q_LORA, M, Q_LORA, D_MODEL);
            hipLaunchKernelGGL(nk_rmsnorm, dim3(M), dim3(256), 0, st, W.Q, Q_LORA, P.q_g + j * Q_LORA, W.CQ, Q_LORA, Q_LORA);
            gemm(st, false, W.CQ, Q_LORA, P.w_uq + (size_t)j * Q_LORA * 1536, 1536, W.Q, 1536, M, 1536, Q_LORA);
            hipLaunchKernelGGL(nk_rope, dim3(1024), dim3(256), 0, st, W.Q, 1536, 128, 192, 8, W.QP, 512, 0, 64, M, T, pos0);
            for (int h = 0; h < NH; ++h) gemm(st, true, W.Q + h * 192, 1536, P.w_uk + h * 128, 1024, W.QL + h * 256, 2048, M, 256, 128);
            if (!sample) {
                for (int b = 0; b < nb; ++b) for (int h = 0; h < NH; ++h) {
                    gemm(st, true, W.QL + (size_t)b * T * 2048 + h * 256, 2048, W.CKV + (size_t)b * T * 256, 256, W.S, T, T, T, 256, 0);
                    gemm(st, true, W.QP + (size_t)b * T * 512 + h * 64, 512, W.KR + (size_t)b * T * 64, 64, W.S, T, T, T, 64, 1);
                    hipLaunchKernelGGL(nk_softmax_causal, dim3(T), dim3(256), 0, st, W.S, T, scale);
                    gemm(st, false, W.S, T, W.CKV + (size_t)b * T * 256, 256, W.OL + (size_t)b * T * 2048 + h * 256, 2048, T, 256, T, 0);
                }
            } else {
                hipLaunchKernelGGL(nk_sattn_scores, dim3(MS), dim3(256), 0, st, W.QL, W.QP, P.cache_ckv, P.cache_kr, P.page_table, W.CKV, W.KR, W.Ss, scale);
                hipLaunchKernelGGL(nk_sattn_softmax, dim3(MS * 8), dim3(256), 0, st, W.Ss);
                hipLaunchKernelGGL(nk_sattn_pv, dim3(MS), dim3(256), 0, st, W.Ss, P.cache_ckv, P.page_table, W.CKV, W.OL);
            }
            for (int h = 0; h < NH; ++h) gemm(st, false, W.OL + h * 256, 2048, P.w_uv + h * 128, 1024, W.O + h * 128, 1024, M, 128, 256);
            gemm(st, false, W.O, 1024, P.w_o + (size_t)j * 1024 * 1024, 1024, W.MO, 1024, M, 1024, 1024);
        }
        hipLaunchKernelGGL(nk_resid_rmsnorm, dim3(M), dim3(256), 0, st, W.X, W.MO, P.post_mix_g + layer * D_MODEL, D_MODEL);
        hipLaunchKernelGGL(nk_rmsnorm, dim3(M), dim3(256), 0, st, W.X, D_MODEL, P.pre_ffn_g + layer * D_MODEL, W.H, D_MODEL, D_MODEL);
        gemm(st, false, W.H, D_MODEL, P.w_up + (size_t)layer * D_MODEL * FF2, FF2, W.A, FF2, M, FF2, D_MODEL);
        hipLaunchKernelGGL(nk_conv_gate, dim3(4096), dim3(256), 0, st, W.A, sample ? P.state_conv + (size_t)layer * nb * 2 * FF2 : (const float*)nullptr,
                           P.conv_w + (size_t)layer * 3 * FF2, P.conv_b + (size_t)layer * FF2, W.GU, out_conv + (size_t)layer * nb * 2 * FF2, nb, T);
        gemm(st, false, W.GU, D_FF, P.w_down + (size_t)layer * D_FF * D_MODEL, D_MODEL, W.MO, D_MODEL, M, D_MODEL, D_FF);
        hipLaunchKernelGGL(nk_resid_rmsnorm, dim3(M), dim3(256), 0, st, W.X, W.MO, P.post_ffn_g + layer * D_MODEL, D_MODEL);
    }
    (void)hipMemcpyAsync(y, W.X, (size_t)M * D_MODEL * 4, hipMemcpyDeviceToDevice, st);
}

extern "C" void kernel_launch(void* const* d_in, const int* in_sizes, int n_in, void* d_out, int out_size, void* d_ws, size_t ws_size, hipStream_t stream) {
    Ptrs P;
    P.x_prompt = (const float*)d_in[0]; P.x_sample = (const float*)d_in[1]; P.cache_ckv = (const float*)d_in[2]; P.cache_kr = (const float*)d_in[3]; P.state_conv = (const float*)d_in[4];
    P.page_table = (const int*)d_in[5]; P.pre_mix_g = (const float*)d_in[6]; P.post_mix_g = (const float*)d_in[7]; P.pre_ffn_g = (const float*)d_in[8]; P.post_ffn_g = (const float*)d_in[9];
    P.w_in_a = (const float*)d_in[10]; P.sgu_g = (const float*)d_in[11]; P.w_s = (const float*)d_in[12]; P.b_s = (const float*)d_in[13]; P.w_out_a = (const float*)d_in[14];
    P.kv_in_g = (const float*)d_in[15]; P.w_dkv = (const float*)d_in[16]; P.kv_g = (const float*)d_in[17]; P.w_uk = (const float*)d_in[18]; P.w_uv = (const float*)d_in[19];
    P.w_dq = (const float*)d_in[20]; P.q_g = (const float*)d_in[21]; P.w_uq = (const float*)d_in[22]; P.w_o = (const float*)d_in[23]; P.w_up = (const float*)d_in[24];
    P.conv_w = (const float*)d_in[25]; P.conv_b = (const float*)d_in[26]; P.w_down = (const float*)d_in[27];

    float* out = (float*)d_out;
    float* y_prompt = out; float* y_sample = y_prompt + (size_t)MP * D_MODEL; float* ckv_p = y_sample + (size_t)MS * D_MODEL; float* kr_p = ckv_p + (size_t)MP * KV_LORA;
    float* conv_p = kr_p + (size_t)MP * QK_ROPE; float* ckv_s = conv_p + (size_t)DEPTH * BATCH * 2 * FF2; float* kr_s = ckv_s + (size_t)MS * KV_LORA;
    float* conv_s = kr_s + (size_t)MS * QK_ROPE; float* chunkv_s = conv_s + (size_t)DEPTH * MS * 2 * FF2;

    static int grid = 0;
    if (grid == 0) {
        int dev = 0, cus = 0;
        if (hipGetDevice(&dev) != hipSuccess || hipDeviceGetAttribute(&cus, hipDeviceAttributeMultiprocessorCount, dev) != hipSuccess) { fprintf(stderr, "kernel_launch: device query failed\n"); grid = -1; return; }
        if (hipFuncSetAttribute((const void*)fwd, hipFuncAttributeMaxDynamicSharedMemorySize, LDS_BYTES) != hipSuccess) { fprintf(stderr, "kernel_launch: hipFuncSetAttribute failed\n"); grid = -1; return; }
        (void)hipGetLastError();
        grid = cus;
    }
    if (grid < 0) return;

    float* w = (float*)((unsigned char*)d_ws + WS_NAIVE); size_t off = 0;
    auto take = [&](size_t n) { float* p = w + off; off += (n + 63) & ~(size_t)63; return p; };
    Bufs W;
    W.X = take((size_t)MP * 1024); W.H = take((size_t)MP * 1024); W.Z = take((size_t)MP * 4096); W.G2 = take((size_t)MP * 2048); W.MO = take((size_t)MP * 1024);
    W.A = take((size_t)MP * FF2); W.GU = take((size_t)MP * D_FF); W.KV = take((size_t)MP * 320); W.CKV = nullptr; W.KR = nullptr;
    W.CQ = take((size_t)MP * 512); W.Q = take((size_t)MP * 1536); W.QL = take((size_t)MP * 2048); W.QP = take((size_t)MP * 512); W.OL = take((size_t)MP * 2048);
    W.O = take((size_t)MP * 1024); W.S = take((size_t)SEQ * SEQ); W.Ss = take((size_t)MS * 8 * SLD);
    if (WS_NAIVE + off * 4 > ws_size) { fprintf(stderr, "workspace too small: need %zu have %zu\n", WS_NAIVE + off * 4, ws_size); return; }

    (void)hipMemsetAsync((char*)d_ws + WS_CTL, 0, CTL_ZERO_BYTES, stream);
    Args a{};
    a.x_prompt = P.x_prompt; a.x_sample = P.x_sample; a.cache_ckv = P.cache_ckv; a.cache_kr = P.cache_kr; a.state_conv = P.state_conv; a.page_table = P.page_table;
    a.pre_mix_g = P.pre_mix_g; a.post_mix_g = P.post_mix_g; a.pre_ffn_g = P.pre_ffn_g; a.post_ffn_g = P.post_ffn_g; a.w_in_a = P.w_in_a; a.sgu_g = P.sgu_g; a.w_s = P.w_s; a.b_s = P.b_s;
    a.w_out_a = P.w_out_a; a.kv_in_g = P.kv_in_g; a.w_dkv = P.w_dkv; a.kv_g = P.kv_g; a.w_uk = P.w_uk; a.w_uv = P.w_uv; a.w_dq = P.w_dq; a.q_g = P.q_g; a.w_uq = P.w_uq; a.w_o = P.w_o;
    a.w_up = P.w_up; a.conv_w = P.conv_w; a.conv_b = P.conv_b; a.w_down = P.w_down; a.out = out; a.ws = (unsigned char*)d_ws;
    for (int ph = 0; ph < NPH_FAST; ++ph) { a.ph_lo = ph; a.ph_hi = ph + 1; hipLaunchKernelGGL(fwd, dim3(grid), dim3(NWAVES * 64), LDS_BYTES, stream, a); }
    { const hipError_t le = hipPeekAtLastError(); if (le != hipSuccess) fprintf(stderr, "kernel_launch: launch failed: %s\n", hipGetErrorName(le)); }

    run_group_naive(stream, P, W, P.x_sample, DEC_BATCH, 1, PAST_LEN, true, 0, y_sample, ckv_s, kr_s, conv_s, chunkv_s);
}
```

```cpp
#include <hip/hip_runtime.h>
#include <cstdio>
#include <cstdint>

constexpr int D_MODEL = 1024, BATCH = 8, SEQ = 2048, DEPTH = 4, DEC_BATCH = 128, PAST_LEN = 8192, PAGE = 128;
constexpr int N_A = 2, CHUNK = 128, SGU_W = 2048, SGU_G = 8, SGU_GD = 256;
constexpr int NH = 8, QK_NOPE = 128, QK_ROPE = 64, V_HEAD = 128, Q_LORA = 512, KV_LORA = 256;
constexpr int D_FF = 2816, FF2 = 5632;
constexpr float EPS = 1e-6f;
constexpr int MP = BATCH * SEQ;
constexpr int MS = DEC_BATCH;
constexpr int NPAGES = PAST_LEN / PAGE;

__device__ __forceinline__ float block_sum_256(float v, float* red) {
    for (int o = 32; o >= 1; o >>= 1) v += __shfl_xor(v, o);
    const int w = threadIdx.x >> 6;
    __syncthreads();
    if ((threadIdx.x & 63) == 0) red[w] = v;
    __syncthreads();
    float s = red[0] + red[1] + red[2] + red[3];
    return s;
}
__device__ __forceinline__ float block_max_256(float v, float* red) {
    for (int o = 32; o >= 1; o >>= 1) v = fmaxf(v, __shfl_xor(v, o));
    const int w = threadIdx.x >> 6;
    __syncthreads();
    if ((threadIdx.x & 63) == 0) red[w] = v;
    __syncthreads();
    return fmaxf(fmaxf(red[0], red[1]), fmaxf(red[2], red[3]));
}

__global__ void __launch_bounds__(256) nk_rmsnorm(const float* in, int ldi, const float* g, float* out, int ldo, int D) {
    __shared__ float red[4];
    const float* r = in + (size_t)blockIdx.x * ldi; float* o = out + (size_t)blockIdx.x * ldo;
    float s = 0.f;
    for (int i = threadIdx.x; i < D; i += 256) { const float v = r[i]; s += v * v; }
    s = block_sum_256(s, red);
    const float rstd = rsqrtf(s / (float)D + EPS);
    for (int i = threadIdx.x; i < D; i += 256) o[i] = r[i] * rstd * g[i];
}
__global__ void __launch_bounds__(256) nk_resid_rmsnorm(float* x, const float* m, const float* g, int D) {
    __shared__ float red[4];
    const float* r = m + (size_t)blockIdx.x * D; float* o = x + (size_t)blockIdx.x * D;
    float s = 0.f;
    for (int i = threadIdx.x; i < D; i += 256) { const float v = r[i]; s += v * v; }
    s = block_sum_256(s, red);
    const float rstd = rsqrtf(s / (float)D + EPS);
    for (int i = threadIdx.x; i < D; i += 256) o[i] += r[i] * rstd * g[i];
}

template <bool TB>
__global__ void __launch_bounds__(256) nk_gemm(const float* __restrict__ A, int lda, const float* __restrict__ B, int ldb, float* C, int ldc, int M, int N, int K, int accum) {
    __shared__ float As[16][65];
    __shared__ float Bs[16][65];
    const int tx = threadIdx.x & 15, ty = threadIdx.x >> 4;
    const int m0 = blockIdx.y * 64, n0 = blockIdx.x * 64;
    float acc[4][4];
#pragma unroll
    for (int i = 0; i < 4; ++i)
#pragma unroll
        for (int j = 0; j < 4; ++j) acc[i][j] = 0.f;
    for (int k0 = 0; k0 < K; k0 += 16) {
#pragma unroll
        for (int i = 0; i < 4; ++i) { const int idx = threadIdx.x + i * 256; const int r = idx >> 4, c = idx & 15; As[c][r] = A[(size_t)(m0 + r) * lda + k0 + c]; }
        if (TB) {
#pragma unroll
            for (int i = 0; i < 4; ++i) { const int idx = threadIdx.x + i * 256; const int r = idx >> 4, c = idx & 15; Bs[c][r] = B[(size_t)(n0 + r) * ldb + k0 + c]; }
        } else {
#pragma unroll
            for (int i = 0; i < 4; ++i) { const int idx = threadIdx.x + i * 256; const int r = idx >> 6, c = idx & 63; Bs[r][c] = B[(size_t)(k0 + r) * ldb + n0 + c]; }
        }
        __syncthreads();
#pragma unroll
        for (int kk = 0; kk < 16; ++kk) {
            float a[4], b[4];
#pragma unroll
            for (int i = 0; i < 4; ++i) { a[i] = As[kk][ty * 4 + i]; b[i] = Bs[kk][tx * 4 + i]; }
#pragma unroll
            for (int i = 0; i < 4; ++i)
#pragma unroll
                for (int j = 0; j < 4; ++j) acc[i][j] += a[i] * b[j];
        }
        __syncthreads();
    }
#pragma unroll
    for (int i = 0; i < 4; ++i)
#pragma unroll
        for (int j = 0; j < 4; ++j) { float* p = C + (size_t)(m0 + ty * 4 + i) * ldc + n0 + tx * 4 + j; *p = accum ? (*p + acc[i][j]) : acc[i][j]; }
}

__global__ void nk_gelu_exact(float* z, size_t n) {
    for (size_t i = (size_t)blockIdx.x * blockDim.x + threadIdx.x; i < n; i += (size_t)gridDim.x * blockDim.x) { const float v = z[i]; z[i] = 0.5f * v * (1.0f + erff(v * 0.70710678118654752f)); }
}

__global__ void __launch_bounds__(256) nk_sgu(const float* Z, const float* ws_, const float* bs_, float* G2, int cl) {
    const int chunk = blockIdx.x, g = blockIdx.y, d = threadIdx.x;
    const float* w = ws_ + (size_t)g * CHUNK * CHUNK; const float* b = bs_ + (size_t)g * CHUNK;
    for (int t = 0; t < cl; ++t) {
        float acc = 0.f;
        for (int s = 0; s <= t; ++s) acc += w[t * CHUNK + s] * Z[(size_t)(chunk * cl + s) * 4096 + 2048 + g * 256 + d];
        acc += b[t];
        const size_t row = (size_t)(chunk * cl + t);
        G2[row * 2048 + g * 256 + d] = Z[row * 4096 + g * 256 + d] * acc;
    }
}

__device__ __forceinline__ float gelu_tanh_f(float x) { const float u = 0.7978845608028654f * (x + 0.044715f * x * x * x); return 0.5f * x * (1.0f + tanhf(u)); }
__global__ void nk_conv_gate(const float* A, const float* prev, const float* cw, const float* cb, float* GU, float* newconv, int nb, int T) {
    const size_t total = (size_t)nb * T * D_FF;
    for (size_t i = (size_t)blockIdx.x * blockDim.x + threadIdx.x; i < total; i += (size_t)gridDim.x * blockDim.x) {
        const int j = (int)(i % D_FF); const size_t row = i / D_FF; const int t = (int)(row % T), b = (int)(row / T);
        float c2[2];
#pragma unroll
        for (int half = 0; half < 2; ++half) {
            const int col = j + half * D_FF; float c = cb[col];
#pragma unroll
            for (int k = 0; k < 3; ++k) { const int tt = t + k - 2; float v;
                if (tt >= 0) v = A[((size_t)b * T + tt) * FF2 + col]; else v = prev ? prev[((size_t)b * 2 + (tt + 2)) * FF2 + col] : 0.f;
                c += v * cw[k * FF2 + col]; }
            c2[half] = c; }
        GU[row * D_FF + j] = gelu_tanh_f(c2[0]) * c2[1];
    }
    const size_t tot2 = (size_t)nb * 2 * FF2;
    for (size_t i = (size_t)blockIdx.x * blockDim.x + threadIdx.x; i < tot2; i += (size_t)gridDim.x * blockDim.x) {
        const int col = (int)(i % FF2); const int r = (int)((i / FF2) % 2); const int b = (int)(i / (2 * FF2));
        const int tt = T - 2 + r; float v;
        if (tt >= 0) v = A[((size_t)b * T + tt) * FF2 + col]; else v = prev ? prev[((size_t)b * 2 + (tt + 2)) * FF2 + col] : 0.f;
        newconv[i] = v;
    }
}

__global__ void nk_rope(const float* X, int ldx, int col0, int cstride, int nblk, float* Y, int ldy, int ycol0, int ycstride, int M, int T, int pos0) {
    const size_t total = (size_t)M * nblk * 32;
    for (size_t i = (size_t)blockIdx.x * blockDim.x + threadIdx.x; i < total; i += (size_t)gridDim.x * blockDim.x) {
        const int k = (int)(i % 32); const int blk = (int)((i / 32) % nblk); const size_t row = i / (32 * nblk);
        const int pos = pos0 + (int)(row % T);
        const float inv = 1.0f / powf(10000.0f, (float)k / 32.0f);
        const float ang = (float)pos * inv;
        float sn, cs; sincosf(ang, &sn, &cs);
        const float x1 = X[row * ldx + col0 + blk * cstride + k], x2 = X[row * ldx + col0 + blk * cstride + k + 32];
        Y[row * ldy + ycol0 + blk * ycstride + k] = x1 * cs - x2 * sn;
        Y[row * ldy + ycol0 + blk * ycstride + k + 32] = x2 * cs + x1 * sn;
    }
}
__global__ void nk_copy2d(const float* X, int ldx, float* Y, int ldy, int rows, int cols) {
    const size_t total = (size_t)rows * cols;
    for (size_t i = (size_t)blockIdx.x * blockDim.x + threadIdx.x; i < total; i += (size_t)gridDim.x * blockDim.x) { const size_t r = i / cols; const int c = (int)(i % cols); Y[r * ldy + c] = X[r * ldx + c]; }
}
__global__ void __launch_bounds__(256) nk_softmax_causal(float* S, int T, float scale) {
    __shared__ float red[4];
    const int t = blockIdx.x; float* r = S + (size_t)t * T;
    float mx = -3.0e38f;
    for (int s = threadIdx.x; s <= t; s += 256) mx = fmaxf(mx, r[s] * scale);
    mx = block_max_256(mx, red);
    float sum = 0.f;
    for (int s = threadIdx.x; s < T; s += 256) { float p = 0.f; if (s <= t) p = __expf(r[s] * scale - mx); r[s] = p; sum += p; }
    sum = block_sum_256(sum, red);
    const float inv = 1.0f / sum;
    for (int s = threadIdx.x; s <= t; s += 256) r[s] *= inv;
}

constexpr int SKEYS = PAST_LEN + 1, SLD = 8200;
__global__ void __launch_bounds__(256) nk_sattn_scores(const float* QL, const float* QP, const float* cache_ckv, const float* cache_kr, const int* page_table, const float* CKVn, const float* KRn, float* Ss, float scale) {
    __shared__ float q[8][320];
    const int b = blockIdx.x;
    for (int i = threadIdx.x; i < 8 * 320; i += 256) { const int h = i / 320, c = i % 320; q[h][c] = c < 256 ? QL[((size_t)b * 8 + h) * 256 + c] : QP[((size_t)b * 8 + h) * 64 + (c - 256)]; }
    __syncthreads();
    for (int key = threadIdx.x; key < SKEYS; key += 256) {
        const float *cr, *kr;
        if (key < PAST_LEN) { const int page = page_table[b * NPAGES + key / PAGE]; const size_t slot = (size_t)page * PAGE + (key % PAGE); cr = cache_ckv + slot * KV_LORA; kr = cache_kr + slot * QK_ROPE; }
        else { cr = CKVn + (size_t)b * KV_LORA; kr = KRn + (size_t)b * QK_ROPE; }
        float acc[8];
#pragma unroll
        for (int h = 0; h < 8; ++h) acc[h] = 0.f;
        for (int c = 0; c < 256; ++c) { const float kv = cr[c];
#pragma unroll
            for (int h = 0; h < 8; ++h) acc[h] += q[h][c] * kv; }
        for (int c = 0; c < 64; ++c) { const float kv = kr[c];
#pragma unroll
            for (int h = 0; h < 8; ++h) acc[h] += q[h][256 + c] * kv; }
#pragma unroll
        for (int h = 0; h < 8; ++h) Ss[((size_t)b * 8 + h) * SLD + key] = acc[h] * scale;
    }
}
__global__ void __launch_bounds__(256) nk_sattn_softmax(float* Ss) {
    __shared__ float red[4];
    float* r = Ss + (size_t)blockIdx.x * SLD;
    float mx = -3.0e38f;
    for (int s = threadIdx.x; s < SKEYS; s += 256) mx = fmaxf(mx, r[s]);
    mx = block_max_256(mx, red);
    float sum = 0.f;
    for (int s = threadIdx.x; s < SKEYS; s += 256) { const float p = __expf(r[s] - mx); r[s] = p; sum += p; }
    sum = block_sum_256(sum, red);
    const float inv = 1.0f / sum;
    for (int s = threadIdx.x; s < SKEYS; s += 256) r[s] *= inv;
}
__global__ void __launch_bounds__(256) nk_sattn_pv(const float* Ss, const float* cache_ckv, const int* page_table, const float* CKVn, float* OL) {
    const int b = blockIdx.x, c = threadIdx.x;
    float acc[8];
#pragma unroll
    for (int h = 0; h < 8; ++h) acc[h] = 0.f;
    for (int key = 0; key < SKEYS; ++key) {
        const float* cr;
        if (key < PAST_LEN) { const int page = page_table[b * NPAGES + key / PAGE]; cr = cache_ckv + ((size_t)page * PAGE + (key % PAGE)) * KV_LORA; } else cr = CKVn + (size_t)b * KV_LORA;
        const float v = cr[c];
#pragma unroll
        for (int h = 0; h < 8; ++h) acc[h] += Ss[((size_t)b * 8 + h) * SLD + key] * v;
    }
#pragma unroll
    for (int h = 0; h < 8; ++h) OL[((size_t)b * 8 + h) * 256 + c] = acc[h];
}

namespace pg8 {
#define PG8_LAS __attribute__((address_space(3)))
typedef unsigned short bf16_t;
typedef short bf16x8 __attribute__((ext_vector_type(8)));
typedef float f32x4 __attribute__((ext_vector_type(4)));
typedef unsigned u32x4 __attribute__((ext_vector_type(4)));
constexpr int BM = 256, BK = 64, HALF = 128, HTB = HALF * BK * 2  , STAGE_BYTES = 8 * HTB, NXCD = 8, WGM = 8;

__host__ __device__ __forceinline__ int lds_byte(int r, int c) { const int st = (r >> 4) * 2 + (c >> 5), rr = r & 15, cc = c & 31, ob = rr * 64 + cc * 2; return st * 1024 + (ob ^ (((ob >> 9) & 1) << 5)); }
__host__ __device__ __forceinline__ void stage_rc(int b, int& R, int& C) { const int st = b / 1024, sb = b % 1024, swz = sb ^ (((sb >> 9) & 1) << 5); R = (st >> 1) * 16 + swz / 64; C = (st & 1) * 32 + (swz % 64) / 2; }
__host__ __device__ __forceinline__ int perm32(int rho) { const int n = rho >> 4, i = rho & 15; return 8 * (i >> 2) + 4 * n + (i & 3); }

__device__ __forceinline__ int lane_id_opaque() { int l; asm volatile("v_mbcnt_lo_u32_b32 %0, -1, 0\n\tv_mbcnt_hi_u32_b32 %0, -1, %0" : "=v"(l)); return l; }
struct Unit { int pm, pn; };
struct Gemm { const bf16_t* A; const bf16_t* Bt; int M, N, K; };

struct StaticOrder {
    int nM, nN, nwg, G, c;
    __host__ __device__ void init(int M, int N, int G_, int c_) { nM = M / BM; nN = N / BM; nwg = nM * nN; G = G_; c = c_; }
    __host__ __device__ bool next(int i, Unit& u) const {
        const long L = (long)i * G + c; if (L >= nwg) return false;
        int wgid = (int)L; { const int q = nwg / NXCD, r = nwg % NXCD, xcd = wgid % NXCD, off = wgid / NXCD; wgid = (xcd < r ? xcd * (q + 1) : r * (q + 1) + (xcd - r) * q) + off; }
        const int nig = WGM * nN, gid = wgid / nig, fm = gid * WGM, gsz = (nM - fm) < WGM ? (nM - fm) : WGM;
        u.pm = fm + ((wgid % nig) % gsz); u.pn = (wgid % nig) / gsz; return true;
    }
    __device__ __forceinline__ void a_ready(const Unit&) const {}
    __device__ __forceinline__ void done(const Unit&) const {}
};

__device__ __forceinline__ unsigned cvt_pk_bf16(float lo, float hi) { unsigned r; asm volatile("v_cvt_pk_bf16_f32 %0, %1, %2" : "=v"(r) : "v"(lo), "v"(hi)); return r; }
typedef float f32x2 __attribute__((ext_vector_type(2)));
__device__ __forceinline__ f32x2 gelu_pk(f32x2 v) {
    const f32x2 av = __builtin_elementwise_abs(v), d = av * 0.2316418882f + 1.0f;
    f32x2 t; t.x = __builtin_amdgcn_rcpf(d.x); t.y = __builtin_amdgcn_rcpf(d.y);
    f32x2 q = t * 0.5307027145f + (-0.7265760135f); q = q * t + 0.7107068705f; q = q * t + (-0.142248368f); q = q * t + 0.127414796f; q = q * t;
    const f32x2 s = (v * v) * (-0.72134752044f);
    f32x2 e; e.x = __builtin_amdgcn_exp2f(s.x); e.y = __builtin_amdgcn_exp2f(s.y);
    const f32x2 m = v * (q * e), r = v - m;
    f32x2 o; o.x = v.x < 0.f ? m.x : r.x; o.y = v.y < 0.f ? m.y : r.y; return o;
}

__device__ __forceinline__ float half_reduce_fq(float s) { s += __shfl_xor(s, 16); s += __shfl_xor(s, 32); return s; }
struct EpiF32SS {
    static constexpr bool PERM = false, AFTER_DRAIN = false;
    float* C; int ldc; float* ss; int ssld;
    __device__ __forceinline__ void operator()(const f32x4 (&acc)[2][2][4][2], const Unit& u, int wr, int wc, int fr, int fq) const {
        const int row0 = u.pm * BM + wr * 64 + fr, col0 = u.pn * BM + wc * 32 + 4 * fq;
#pragma unroll
        for (int ai = 0; ai < 2; ++ai)
#pragma unroll
            for (int m = 0; m < 4; ++m) { const int row = row0 + ai * HALF + m * 16; float* rowp = C + (size_t)row * ldc + col0; float s = 0.f;
#pragma unroll
                for (int bj = 0; bj < 2; ++bj)
#pragma unroll
                    for (int n = 0; n < 2; ++n) { const f32x4 v = acc[ai][bj][m][n]; *(f32x4*)(rowp + bj * HALF + n * 16) = v; s += (v[0] * v[0] + v[1] * v[1]) + (v[2] * v[2] + v[3] * v[3]); }
                s = half_reduce_fq(s);
                if (fq == 0) ss[(size_t)row * ssld + u.pn * 4 + wc] = s; }
    }
};
struct EpiZ {
    static constexpr bool PERM = true, AFTER_DRAIN = false;
    bf16_t* U; bf16_t* V; const float* rstd; float* vss;
    __device__ __forceinline__ void operator()(const f32x4 (&acc)[2][2][4][2], const Unit& u, int wr, int wc, int fr, int fq) const {
        const int row0 = u.pm * BM + wr * 64 + fr; const bool isv = u.pn >= 8; bf16_t* base = isv ? V : U; const int col0 = (u.pn & 7) * BM + wc * 32 + 8 * fq;
#pragma unroll
        for (int ai = 0; ai < 2; ++ai)
#pragma unroll
            for (int m = 0; m < 4; ++m) { const int row = row0 + ai * HALF + m * 16; const float rs = rstd[row]; bf16_t* rowp = base + (size_t)row * 2048 + col0; float s = 0.f;
#pragma unroll
                for (int bj = 0; bj < 2; ++bj) { f32x4 v0 = acc[ai][bj][m][0] * rs, v1 = acc[ai][bj][m][1] * rs;
                    { f32x2 a = gelu_pk((f32x2){v0[0], v0[1]}), b = gelu_pk((f32x2){v0[2], v0[3]}), c = gelu_pk((f32x2){v1[0], v1[1]}), d = gelu_pk((f32x2){v1[2], v1[3]});
                      v0 = (f32x4){a.x, a.y, b.x, b.y}; v1 = (f32x4){c.x, c.y, d.x, d.y}; }
                    s += (v0[0] * v0[0] + v0[1] * v0[1]) + (v0[2] * v0[2] + v0[3] * v0[3]) + (v1[0] * v1[0] + v1[1] * v1[1]) + (v1[2] * v1[2] + v1[3] * v1[3]);
                    u32x4 w; w.x = cvt_pk_bf16(v0[0], v0[1]); w.y = cvt_pk_bf16(v0[2], v0[3]); w.z = cvt_pk_bf16(v1[0], v1[1]); w.w = cvt_pk_bf16(v1[2], v1[3]);
                    *(u32x4*)(rowp + bj * HALF) = w; }
                if (isv) { s = half_reduce_fq(s); if (fq == 0) vss[(size_t)row * 32 + (u.pn - 8) * 4 + wc] = s; } }
    }
};
struct EpiUp {
    static constexpr bool PERM = true, AFTER_DRAIN = false;
    bf16_t* AB; const float* rstd; float* conv_out;
    __device__ __forceinline__ void operator()(const f32x4 (&acc)[2][2][4][2], const Unit& u, int wr, int wc, int fr, int fq) const {
        const int row0 = u.pm * BM + wr * 64 + fr, col0 = u.pn * BM + wc * 32 + 8 * fq;
#pragma unroll
        for (int ai = 0; ai < 2; ++ai)
#pragma unroll
            for (int m = 0; m < 4; ++m) { const int row = row0 + ai * HALF + m * 16; const float rs = rstd[row]; bf16_t* rowp = AB + (size_t)row * 5632 + col0; const int t = row & 2047;
#pragma unroll
                for (int bj = 0; bj < 2; ++bj) { const f32x4 v0 = acc[ai][bj][m][0] * rs, v1 = acc[ai][bj][m][1] * rs;
                    u32x4 w; w.x = cvt_pk_bf16(v0[0], v0[1]); w.y = cvt_pk_bf16(v0[2], v0[3]); w.z = cvt_pk_bf16(v1[0], v1[1]); w.w = cvt_pk_bf16(v1[2], v1[3]);
                    *(u32x4*)(rowp + bj * HALF) = w;
                    if (t >= 2046) { float* o = conv_out + ((size_t)(row >> 11) * 2 + (t - 2046)) * 5632 + col0 + bj * HALF; *(f32x4*)o = v0; *(f32x4*)(o + 4) = v1; } } }
    }
};
struct EpiDq {
    static constexpr bool PERM = true, AFTER_DRAIN = false;
    bf16_t* CQ; const float* rstd; float* cqss; float* KVR;
    __device__ __forceinline__ void operator()(const f32x4 (&acc)[2][2][4][2], const Unit& u, int wr, int wc, int fr, int fq) const {
        const int row0 = u.pm * BM + wr * 64 + fr, col0 = u.pn * BM + wc * 32 + 8 * fq; const bool iscq = u.pn < 2;
#pragma unroll
        for (int ai = 0; ai < 2; ++ai)
#pragma unroll
            for (int m = 0; m < 4; ++m) { const int row = row0 + ai * HALF + m * 16; const float rs = rstd[row]; float s = 0.f;
#pragma unroll
                for (int bj = 0; bj < 2; ++bj) { const f32x4 v0 = acc[ai][bj][m][0] * rs, v1 = acc[ai][bj][m][1] * rs; const int c = col0 + bj * HALF;
                    if (iscq) { s += (v0[0] * v0[0] + v0[1] * v0[1]) + (v0[2] * v0[2] + v0[3] * v0[3]) + (v1[0] * v1[0] + v1[1] * v1[1]) + (v1[2] * v1[2] + v1[3] * v1[3]);
                        u32x4 w; w.x = cvt_pk_bf16(v0[0], v0[1]); w.y = cvt_pk_bf16(v0[2], v0[3]); w.z = cvt_pk_bf16(v1[0], v1[1]); w.w = cvt_pk_bf16(v1[2], v1[3]);
                        *(u32x4*)(CQ + (size_t)row * 512 + c) = w; }
                    else if (c - 512 < 320) { float* o = KVR + (size_t)row * 320 + (c - 512); *(f32x4*)o = v0; *(f32x4*)(o + 4) = v1; } }
                if (iscq) { s = half_reduce_fq(s); if (fq == 0) cqss[(size_t)row * 8 + u.pn * 4 + wc] = s; } }
    }
};
struct EpiQ {
    static constexpr bool PERM = true, AFTER_DRAIN = false;
    bf16_t* Q; const float* cqss; const float* rope;
    __device__ __forceinline__ void operator()(const f32x4 (&acc)[2][2][4][2], const Unit& u, int wr, int wc, int fr, int fq) const {
        const int row0 = u.pm * BM + wr * 64 + fr, col0 = u.pn * BM + wc * 32 + 8 * fq;
#pragma unroll
        for (int ai = 0; ai < 2; ++ai)
#pragma unroll
            for (int m = 0; m < 4; ++m) { const int row = row0 + ai * HALF + m * 16; const f32x4 p0 = *(const f32x4*)(cqss + (size_t)row * 8), p1 = *(const f32x4*)(cqss + (size_t)row * 8 + 4);
                const float rs = rsqrtf(((p0[0] + p0[1]) + (p0[2] + p0[3]) + (p1[0] + p1[1]) + (p1[2] + p1[3])) * (1.0f / 512.0f) + 1e-6f); const int pos = row & 2047;
#pragma unroll
                for (int bj = 0; bj < 2; ++bj) { f32x4 v0 = acc[ai][bj][m][0] * rs, v1 = acc[ai][bj][m][1] * rs; const int c = col0 + bj * HALF; const int cin = c % 192;
                    if (cin >= 128) { const int i0 = (cin - 128) >> 1; const f32x4 t0 = *(const f32x4*)(rope + ((size_t)pos * 32 + i0) * 2), t1 = *(const f32x4*)(rope + ((size_t)pos * 32 + i0 + 2) * 2);
                        const f32x4 a = v0, b = v1;
                        v0[0] = a[0] * t0[0] - a[1] * t0[1]; v0[1] = a[1] * t0[0] + a[0] * t0[1]; v0[2] = a[2] * t0[2] - a[3] * t0[3]; v0[3] = a[3] * t0[2] + a[2] * t0[3];
                        v1[0] = b[0] * t1[0] - b[1] * t1[1]; v1[1] = b[1] * t1[0] + b[0] * t1[1]; v1[2] = b[2] * t1[2] - b[3] * t1[3]; v1[3] = b[3] * t1[2] + b[2] * t1[3]; }
                    u32x4 w; w.x = cvt_pk_bf16(v0[0], v0[1]); w.y = cvt_pk_bf16(v0[2], v0[3]); w.z = cvt_pk_bf16(v1[0], v1[1]); w.w = cvt_pk_bf16(v1[2], v1[3]);
                    *(u32x4*)(Q + (size_t)row * 1536 + c) = w; } }
    }
};
struct EpiBf {
    static constexpr bool PERM = true, AFTER_DRAIN = false;
    bf16_t* O; int ldc;
    __device__ __forceinline__ void operator()(const f32x4 (&acc)[2][2][4][2], const Unit& u, int wr, int wc, int fr, int fq) const {
        const int row0 = u.pm * BM + wr * 64 + fr, col0 = u.pn * BM + wc * 32 + 8 * fq;
#pragma unroll
        for (int ai = 0; ai < 2; ++ai)
#pragma unroll
            for (int m = 0; m < 4; ++m) { bf16_t* rowp = O + (size_t)(row0 + ai * HALF + m * 16) * ldc + col0;
#pragma unroll
                for (int bj = 0; bj < 2; ++bj) { const f32x4 v0 = acc[ai][bj][m][0], v1 = acc[ai][bj][m][1];
                    u32x4 w; w.x = cvt_pk_bf16(v0[0], v0[1]); w.y = cvt_pk_bf16(v0[2], v0[3]); w.z = cvt_pk_bf16(v1[0], v1[1]); w.w = cvt_pk_bf16(v1[2], v1[3]);
                    *(u32x4*)(rowp + bj * HALF) = w; } }
    }
};
template <class Epi, class Sched, bool ALIGN_EPI = false, bool SP2 = false>
__device__ __forceinline__ void gemm_phase(PG8_LAS unsigned char* lds, const Gemm g, const Sched& S, const Epi& E, const int wave_id_) {
    const int tid_ = wave_id_ * 64 + lane_id_opaque();
    const int tid = tid_, wid = __builtin_amdgcn_readfirstlane(tid >> 6), lane = tid & 63, wr = wid >> 2, wc = wid & 3, fr = lane & 15, fq = lane >> 4;
    const int K = g.K, nt = K / BK;
    unsigned voffA[2], voffB[2];
#pragma unroll
    for (int i = 0; i < 2; ++i) { int R, C; stage_rc(tid * 16 + i * 8192, R, C); const int Rb = Epi::PERM ? ((R & ~31) + perm32(R & 31)) : R;
        voffA[i] = (unsigned)(R * K + C) * 2u; voffB[i] = (unsigned)(Rb * K + C) * 2u; }
    const size_t kstep = (size_t)(BK * 2);
    const size_t hstep = (size_t)HALF * K * 2;
    const size_t tstep = 2 * hstep;
    const unsigned ldsw = (unsigned)wid * 1024u;
    const int aoff = lds_byte(wr * 64 + fr, fq * 8), boff = lds_byte(wc * 32 + fr, fq * 8);
#define PG8_SA(b, h) (((b) * 2 + (h)) * HTB)
#define PG8_SB(b, h) ((4 + (b) * 2 + (h)) * HTB)
#define PG8_STAGE(bufoff, gbase, voff) do { _Pragma("unroll") for (int _i = 0; _i < 2; ++_i) \
        __builtin_amdgcn_global_load_lds((const unsigned*)((const char*)(gbase) + (voff)[_i]), (PG8_LAS unsigned*)(lds + (bufoff) + ldsw + _i * 8192), 16, 0, 0); } while (0)
#define PG8_LDA(dst, b, h) do { _Pragma("unroll") for (int m = 0; m < 4; ++m) _Pragma("unroll") for (int k = 0; k < 2; ++k) dst[m][k] = *(const PG8_LAS bf16x8*)(lds + PG8_SA(b, h) + aoff + m * 2048 + k * 1024); } while (0)
#define PG8_LDB(dst, b, h) do { _Pragma("unroll") for (int n = 0; n < 2; ++n) _Pragma("unroll") for (int k = 0; k < 2; ++k) dst[n][k] = *(const PG8_LAS bf16x8*)(lds + PG8_SB(b, h) + boff + n * 2048 + k * 1024); } while (0)
#define PG8_MMA(ai, bj, At, Bt) do { __builtin_amdgcn_s_setprio(1); _Pragma("unroll") for (int m = 0; m < 4; ++m) _Pragma("unroll") for (int n = 0; n < 2; ++n) _Pragma("unroll") for (int k = 0; k < 2; ++k) \
        acc[ai][bj][m][n] = __builtin_amdgcn_mfma_f32_16x16x32_bf16(Bt[n][k], At[m][k], acc[ai][bj][m][n], 0, 0, 0); __builtin_amdgcn_s_setprio(0); } while (0)
#define PG8_WAIT_V(n) asm volatile("s_waitcnt vmcnt(" #n ")" ::: "memory")
#define PG8_WAIT_L(n) asm volatile("s_waitcnt lgkmcnt(" #n ")" ::: "memory")
#define PG8_BAR __builtin_amdgcn_s_barrier()
#define PG8_SCHED __builtin_amdgcn_sched_barrier(0)
    Unit cur, nxt; int ui = 0;
    if (!S.next(0, cur)) return;
    f32x4 acc[2][2][4][2];
#pragma unroll
    for (int a = 0; a < 2; ++a)
#pragma unroll
        for (int b = 0; b < 2; ++b)
#pragma unroll
            for (int m = 0; m < 4; ++m)
#pragma unroll
                for (int n = 0; n < 2; ++n) acc[a][b][m][n] = (f32x4){0.f, 0.f, 0.f, 0.f};
    bf16x8 At[4][2], B0[2][2], B1[2][2];
    const char* cA = (const char*)g.A + (size_t)cur.pm * tstep; const char* cB = (const char*)g.Bt + (size_t)cur.pn * tstep;
    S.a_ready(cur);
    if constexpr (SP2) {
        PG8_STAGE(PG8_SB(0, 0), cB, voffB); PG8_STAGE(PG8_SB(0, 1), cB + hstep, voffB); PG8_STAGE(PG8_SA(0, 0), cA, voffA); PG8_STAGE(PG8_SA(0, 1), cA + hstep, voffA);
        if (wr == 1) PG8_BAR;
        PG8_WAIT_V(2); PG8_BAR;
        PG8_STAGE(PG8_SB(1, 0), cB + kstep, voffB); PG8_STAGE(PG8_SA(1, 0), cA + kstep, voffA); PG8_STAGE(PG8_SB(1, 1), cB + hstep + kstep, voffB);
        PG8_WAIT_V(6); PG8_BAR;
    } else {
        PG8_STAGE(PG8_SB(0, 0), cB, voffB); PG8_STAGE(PG8_SA(0, 0), cA, voffA); PG8_STAGE(PG8_SB(0, 1), cB + hstep, voffB); PG8_STAGE(PG8_SA(0, 1), cA + hstep, voffA);
        if (wr == 1) PG8_BAR;
        PG8_WAIT_V(4); PG8_BAR;
        PG8_STAGE(PG8_SB(1, 0), cB + kstep, voffB); PG8_STAGE(PG8_SA(1, 0), cA + kstep, voffA); PG8_STAGE(PG8_SB(1, 1), cB + hstep + kstep, voffB);
        PG8_WAIT_V(6); PG8_BAR;
    }
    for (;;) {
        const bool has_next = S.next(ui + 1, nxt);
        const char* nA = has_next ? (const char*)g.A + (size_t)nxt.pm * tstep : cA; const char* nB = has_next ? (const char*)g.Bt + (size_t)nxt.pn * tstep : cB;
        for (int t = 0; t < nt; t += 2) {
            const bool last = (t == nt - 2);
            const char* a1 = cA + (size_t)(t + 1) * kstep;
            const char* a2 = last ? nA : cA + (size_t)(t + 2) * kstep; const char* b2 = last ? nB : cB + (size_t)(t + 2) * kstep;
            const char* a3 = a2 + kstep; const char* b3 = b2 + kstep;
            if (last && has_next) S.a_ready(nxt);
            if constexpr (SP2) {
            PG8_LDB(B0, 0, 0); PG8_LDB(B1, 0, 1); PG8_SCHED; PG8_LDA(At, 0, 0); PG8_STAGE(PG8_SA(1, 1), a1 + hstep, voffA);
            PG8_WAIT_V(8); PG8_WAIT_L(0); PG8_BAR; PG8_MMA(0, 0, At, B0); PG8_MMA(0, 1, At, B1); PG8_BAR; PG8_SCHED;
            PG8_LDA(At, 0, 1); PG8_STAGE(PG8_SB(0, 0), b2, voffB); PG8_STAGE(PG8_SB(0, 1), b2 + hstep, voffB); PG8_STAGE(PG8_SA(0, 0), a2, voffA);
            PG8_WAIT_V(8); PG8_WAIT_L(0); PG8_BAR; PG8_MMA(1, 0, At, B0); PG8_MMA(1, 1, At, B1); PG8_BAR; PG8_SCHED;
            PG8_LDB(B0, 1, 0); PG8_LDB(B1, 1, 1); PG8_SCHED; PG8_LDA(At, 1, 0); PG8_STAGE(PG8_SA(0, 1), a2 + hstep, voffA);
            PG8_WAIT_V(8); PG8_WAIT_L(0); PG8_BAR; PG8_MMA(0, 0, At, B0); PG8_MMA(0, 1, At, B1); PG8_BAR; PG8_SCHED;
            PG8_LDA(At, 1, 1); PG8_STAGE(PG8_SB(1, 0), b3, voffB); PG8_STAGE(PG8_SB(1, 1), b3 + hstep, voffB); PG8_STAGE(PG8_SA(1, 0), a3, voffA);
            PG8_WAIT_V(8); PG8_WAIT_L(0); PG8_BAR; PG8_MMA(1, 0, At, B0); PG8_MMA(1, 1, At, B1); PG8_BAR; PG8_SCHED;
            } else {
            PG8_LDB(B0, 0, 0); PG8_SCHED; PG8_LDA(At, 0, 0); PG8_STAGE(PG8_SA(1, 1), a1 + hstep, voffA);
            PG8_WAIT_L(8); PG8_BAR; PG8_WAIT_L(0); PG8_MMA(0, 0, At, B0); PG8_BAR; PG8_SCHED;
            PG8_LDB(B1, 0, 1); PG8_STAGE(PG8_SB(0, 0), b2, voffB);
            PG8_BAR; PG8_WAIT_L(0); PG8_MMA(0, 1, At, B1); PG8_BAR;
            PG8_LDA(At, 0, 1); PG8_STAGE(PG8_SA(0, 0), a2, voffA);
            PG8_BAR; PG8_WAIT_L(0); PG8_MMA(1, 0, At, B0); PG8_BAR; PG8_SCHED;
            PG8_STAGE(PG8_SB(0, 1), b2 + hstep, voffB);
            PG8_WAIT_V(6); PG8_BAR; PG8_MMA(1, 1, At, B1); PG8_BAR;
            PG8_LDB(B0, 1, 0); PG8_SCHED; PG8_LDA(At, 1, 0); PG8_STAGE(PG8_SA(0, 1), a2 + hstep, voffA);
            PG8_WAIT_L(8); PG8_BAR; PG8_WAIT_L(0); PG8_MMA(0, 0, At, B0); PG8_BAR; PG8_SCHED;
            PG8_LDB(B1, 1, 1); PG8_STAGE(PG8_SB(1, 0), b3, voffB);
            PG8_BAR; PG8_WAIT_L(0); PG8_MMA(0, 1, At, B1); PG8_BAR;
            PG8_LDA(At, 1, 1); PG8_STAGE(PG8_SA(1, 0), a3, voffA);
            PG8_BAR; PG8_WAIT_L(0); PG8_MMA(1, 0, At, B0); PG8_BAR; PG8_SCHED;
            PG8_STAGE(PG8_SB(1, 1), b3 + hstep, voffB);
            PG8_WAIT_V(6); PG8_BAR; PG8_MMA(1, 1, At, B1); PG8_BAR;
            }
        }
        if constexpr (ALIGN_EPI) { if (wr == 0) PG8_BAR; }
        if constexpr (!Epi::AFTER_DRAIN) { E(acc, cur, wr, wc, fr, fq); S.done(cur); }
        if (!has_next) break;
#pragma unroll
        for (int a = 0; a < 2; ++a)
#pragma unroll
            for (int b = 0; b < 2; ++b)
#pragma unroll
                for (int m = 0; m < 4; ++m)
#pragma unroll
                    for (int n = 0; n < 2; ++n) acc[a][b][m][n] = (f32x4){0.f, 0.f, 0.f, 0.f};
        cur = nxt; cA = nA; cB = nB; ++ui;
        if constexpr (ALIGN_EPI) { if (wr == 1) PG8_BAR; }
    }
    PG8_WAIT_V(0);
    if constexpr (!ALIGN_EPI) { if (wr == 0) PG8_BAR; }
    PG8_BAR;
    if constexpr (Epi::AFTER_DRAIN) { E.fused(acc, cur, wr, wc, fr, fq, lds, wid, lane); S.done(cur); }
#undef PG8_SA
#undef PG8_SB
#undef PG8_STAGE
#undef PG8_LDA
#undef PG8_LDB
#undef PG8_MMA
#undef PG8_WAIT_V
#undef PG8_WAIT_L
#undef PG8_BAR
#undef PG8_SCHED
}
}
#define GAS __attribute__((address_space(1)))
#define LAS __attribute__((address_space(3)))
typedef unsigned short bf16;
typedef unsigned v4u __attribute__((ext_vector_type(4)));
typedef unsigned v2u __attribute__((ext_vector_type(2)));
typedef float f32x4 __attribute__((ext_vector_type(4)));
typedef float f32x2 __attribute__((ext_vector_type(2)));
typedef float f32x16 __attribute__((ext_vector_type(16)));
typedef short bf16x8 __attribute__((ext_vector_type(8)));
typedef short s16x4 __attribute__((ext_vector_type(4)));
typedef GAS unsigned gu32;
#define LDS_WAIT() asm volatile("s_waitcnt lgkmcnt(0)" ::: "memory")
#define VM_WAIT() asm volatile("s_waitcnt vmcnt(0)" ::: "memory")
__device__ __forceinline__ unsigned f2bf(float f) { unsigned u = __builtin_bit_cast(unsigned, f); return (u + 0x7fffu + ((u >> 16) & 1u)) >> 16; }
__device__ __forceinline__ unsigned pk2(float lo, float hi) { return f2bf(lo) | (f2bf(hi) << 16); }
__device__ __forceinline__ float bflo(unsigned w) { return __builtin_bit_cast(float, w << 16); }
__device__ __forceinline__ float bfhi(unsigned w) { return __builtin_bit_cast(float, w & 0xffff0000u); }
#define XB_TMO      128
#define XB_XCNT(j)  (256  + 64 * (j))
#define XB_XSUB(j)  (1280 + 64 * (j))
#define XB_XGEN(j)  (2304 + 64 * (j))
#define XB_TOP      3328
#define XB_TOPGEN   3392
#define XCD_BAR_WORDS 3456
#define XB_SPIN_CAP (1u << 18)

__device__ __forceinline__ unsigned xb_ld(unsigned* p)              { return __hip_atomic_load(p, __ATOMIC_RELAXED, __HIP_MEMORY_SCOPE_AGENT); }
__device__ __forceinline__ unsigned xb_add(unsigned* p, unsigned v) { return __hip_atomic_fetch_add(p, v, __ATOMIC_RELAXED, __HIP_MEMORY_SCOPE_AGENT); }
__device__ __forceinline__ unsigned xb_xcc_id() { return (unsigned)__builtin_amdgcn_s_getreg((3 << 11) | 20) & 0xFu; }
#define XB_SPIN(cond, bar) do { unsigned _sp = 0; while (cond) { __builtin_amdgcn_s_sleep(1); \
    if ((++_sp & 255u) == 0u) { if (xb_ld(&(bar)[XB_TMO])) break; if (_sp > XB_SPIN_CAP) { atomicAdd(&(bar)[XB_TMO], 1u); break; } } } } while (0)

struct XcdBarrier {
    unsigned* bar; unsigned x;
    volatile LAS unsigned* st;
};

__device__ __forceinline__ XcdBarrier xcd_barrier_post(unsigned* bar, volatile LAS unsigned* st, const bool thread0) {
    XcdBarrier b; b.bar = bar; b.x = xb_xcc_id(); b.st = st;
    if (thread0) (void)xb_add(&bar[XB_XCNT(b.x)], 1u);
    return b;
}
__device__ __forceinline__ void xcd_barrier_complete(unsigned* bar, unsigned x, unsigned& nloc, unsigned& nx) {
    const unsigned G = gridDim.x * gridDim.y * gridDim.z;
    unsigned sum, cnt, mine, sp = 0u;
    for (;;) {
        sum = 0u; cnt = 0u; mine = 0u;
#pragma unroll
        for (unsigned j = 0; j < 16; ++j) { const unsigned c = xb_ld(&bar[XB_XCNT(j)]); sum += c; cnt += (c > 0u) ? 1u : 0u; mine = (j == x) ? c : mine; }
        if (sum == G) break;
        __builtin_amdgcn_s_sleep(1);
        if ((++sp & 255u) == 0u) { if (xb_ld(&bar[XB_TMO])) break; if (sp > XB_SPIN_CAP) { atomicAdd(&bar[XB_TMO], 1u); break; } }
    }
    nloc = mine > 0u ? mine : 1u; nx = cnt > 0u ? cnt : 1u;
}

__device__ __forceinline__ void xcd_barrier(const XcdBarrier& b, const bool thread0) {
    asm volatile("s_waitcnt vmcnt(0)" ::: "memory");
    __syncthreads();
    if (thread0) {
        unsigned* bar = b.bar;
        __builtin_amdgcn_s_waitcnt(0);
        unsigned nloc = b.st[0], nx = b.st[1];
        if (nloc == 0u) { xcd_barrier_complete(bar, b.x, nloc, nx); b.st[0] = nloc; b.st[1] = nx; }
        const unsigned old = xb_add(&bar[XB_XSUB(b.x)], 1u);
        const unsigned gen = old / nloc;
        if (old + 1u == (gen + 1u) * nloc) {
            __builtin_amdgcn_fence(__ATOMIC_RELEASE, "agent");
            asm volatile("s_waitcnt vmcnt(0)" ::: "memory");
            const unsigned og = xb_add(&bar[XB_TOP], 1u);
            const unsigned tg = og / nx;
            if (og + 1u == (tg + 1u) * nx) xb_add(&bar[XB_TOPGEN], 1u);
            else XB_SPIN(xb_ld(&bar[XB_TOPGEN]) == tg, bar);
            __builtin_amdgcn_fence(__ATOMIC_ACQUIRE, "agent");
            xb_add(&bar[XB_XGEN(b.x)], 1u);
            asm volatile("s_waitcnt vmcnt(0)" ::: "memory");
        } else {
            XB_SPIN(xb_ld(&bar[XB_XGEN(b.x)]) == gen, bar);
            __builtin_amdgcn_fence(__ATOMIC_ACQUIRE, "agent");
            asm volatile("s_waitcnt vmcnt(0)" ::: "memory");
        }
    }
    __syncthreads();
}
constexpr size_t MiB = 1u << 20;
constexpr size_t WS_CTL = 0, CTL_ZERO_BYTES = 1 * MiB;
constexpr size_t WS_WIN = 2 * MiB;
constexpr size_t WS_WOUT = WS_WIN + 16 * MiB;
constexpr size_t WS_WUP = WS_WOUT + 8 * MiB;
constexpr size_t WS_WDN = WS_WUP + 44 * MiB;
constexpr size_t WS_WDQ0 = WS_WDN + 22 * MiB;
constexpr size_t WS_WDQ1 = WS_WDQ0 + 2 * MiB;
constexpr size_t WS_WUQ = WS_WDQ1 + 1 * MiB;
constexpr size_t WS_WKV = WS_WUQ + 3 * MiB;
constexpr size_t WS_WUKN = WS_WKV + 1 * MiB;
constexpr size_t WS_WO = WS_WUKN + 1 * MiB;
constexpr size_t WS_ROPE = WS_WO + 4 * MiB;
constexpr size_t WS_X = WS_ROPE + 1 * MiB;
constexpr size_t WS_XB = WS_X + 64 * MiB;
constexpr size_t WS_RSTD = WS_XB + 32 * MiB;
constexpr size_t WS_U = WS_RSTD + 1 * MiB;
constexpr size_t WS_V = WS_U + 64 * MiB;
constexpr size_t WS_VSS = WS_V + 64 * MiB;
constexpr size_t WS_G2 = WS_VSS + 2 * MiB;
constexpr size_t WS_MO = WS_G2 + 64 * MiB;
constexpr size_t WS_MSS = WS_MO + 64 * MiB;
constexpr size_t WS_AB = WS_MSS + 1 * MiB;
constexpr size_t WS_GU = WS_AB + 176 * MiB;
constexpr size_t WS_CQ = WS_GU + 88 * MiB;
constexpr size_t WS_CQSS = WS_CQ + 16 * MiB;
constexpr size_t WS_KVR = WS_CQSS + 1 * MiB;
constexpr size_t WS_Q = WS_KVR + 20 * MiB;
constexpr size_t WS_CKVB = WS_Q + 48 * MiB;
constexpr size_t WS_KRB = WS_CKVB + 8 * MiB;
constexpr size_t WS_KN = WS_KRB + 2 * MiB;
constexpr size_t WS_VT = WS_KN + 32 * MiB;
constexpr size_t WS_OB = WS_VT + 32 * MiB;
constexpr size_t WS_FAST_END = WS_OB + 32 * MiB;
constexpr size_t WS_NAIVE = 1024 * MiB;
static_assert(WS_FAST_END <= WS_NAIVE, "ws map");
constexpr int CW_TMO = 0, CW_CODE = 1, CW_BAR = 4096;
constexpr int RING_OFF = 0, RING_BYTES = 131072;
constexpr int LDSCTL_OFF = RING_BYTES, MISC_OFF = LDSCTL_OFF + 320;
constexpr int LDS_BYTES = 147456;
constexpr int NWAVES = 8;
constexpr float LOG2E = 1.4426950408889634f;

struct Frame { LAS unsigned char* lds; volatile LAS unsigned* MISC; gu32* ctl; int tid, lane, wave, vcu, G; };
#define CAS __attribute__((address_space(4)))
struct Args {
    const GAS float *x_prompt, *x_sample, *cache_ckv, *cache_kr, *state_conv; const GAS int* page_table;
    const GAS float *pre_mix_g, *post_mix_g, *pre_ffn_g, *post_ffn_g, *w_in_a, *sgu_g, *w_s, *b_s, *w_out_a, *kv_in_g, *w_dkv, *kv_g, *w_uk, *w_uv, *w_dq, *q_g, *w_uq, *w_o, *w_up, *conv_w, *conv_b, *w_down;
    GAS float* out; GAS unsigned char* ws; int ph_lo, ph_hi;
};
typedef const CAS Args* ArgsP;
__device__ __forceinline__ float wave_sum(float v) {
#pragma unroll
    for (int o = 1; o < 64; o <<= 1) v += __shfl_xor(v, o);
    return v;
}
__device__ __forceinline__ void p0_transpose_item(const float* W, int K, int N, bf16* WT, int row_off, const float* kscale, float cscale, int mode, LAS float* scr, int item, int lane) {
    const int nblk = N / 32, kb = item / nblk, nb = item % nblk, k0 = 64 * kb, n0 = 32 * nb;
#pragma unroll 8
    for (int i = 0; i < 32; ++i) { const int kk = 2 * i + (lane >> 5); const float sc = (kscale ? kscale[k0 + kk] : 1.0f) * cscale; scr[kk * 33 + (lane & 31)] = W[(size_t)(k0 + kk) * N + n0 + (lane & 31)] * sc; }
    LDS_WAIT(); asm volatile("" ::: "memory");
    const int c = lane & 7;
#pragma unroll
    for (int j = 0; j < 4; ++j) { const int n = (lane >> 3) + 8 * j; const LAS float* s = scr + (8 * c) * 33 + n;
        v4u o; o.x = pk2(s[0 * 33], s[1 * 33]); o.y = pk2(s[2 * 33], s[3 * 33]); o.z = pk2(s[4 * 33], s[5 * 33]); o.w = pk2(s[6 * 33], s[7 * 33]);
        int dr = n0 + n;
        if (mode == 2) { const int h = dr / 192, cin = dr % 192; if (cin >= 128) { const int i = cin - 128; dr = h * 192 + 128 + 2 * (i & 31) + (i >> 5); } }
        *(GAS v4u*)(WT + (size_t)(row_off + dr) * K + k0 + 8 * c) = o; }
    LDS_WAIT(); asm volatile("" ::: "memory");
}
__device__ __forceinline__ void p0_prologue(Frame& F, ArgsP Ap) {
    GAS unsigned char* ws = Ap->ws;
    LAS float* scr = (LAS float*)(F.lds + RING_OFF + F.wave * 16384);
    const int gw = F.vcu * NWAVES + F.wave, NGW = F.G * NWAVES;
    constexpr int I_IN = 16 * 128, I_OUT = 32 * 32, I_UP = 16 * 176, I_DN = 44 * 32, I_DQ = 16 * 16, I_DKV = 16 * 10, I_UQ = 8 * 48, I_KV = 4 * 32, I_O = 16 * 32;
    constexpr int NITEMS = 2 * I_IN + 2 * I_OUT + 4 * I_UP + 4 * I_DN + 2 * I_DQ + I_DKV + 2 * I_UQ + 2 * I_KV + 2 * I_O;
    for (int it = gw; it < NITEMS; it += NGW) {
        int r = it;
        if (r < 2 * I_IN) { const int l = r / I_IN; p0_transpose_item(((const float*)Ap->w_in_a) + (size_t)l * 1024 * 4096, 1024, 4096, (bf16*)(ws + WS_WIN) + (size_t)l * 4096 * 1024, 0, ((const float*)Ap->pre_mix_g) + l * 1024, 1.0f, 0, scr, r % I_IN, F.lane); continue; } r -= 2 * I_IN;
        if (r < 2 * I_OUT) { const int l = r / I_OUT; p0_transpose_item(((const float*)Ap->w_out_a) + (size_t)l * 2048 * 1024, 2048, 1024, (bf16*)(ws + WS_WOUT) + (size_t)l * 1024 * 2048, 0, nullptr, 1.0f, 0, scr, r % I_OUT, F.lane); continue; } r -= 2 * I_OUT;
        if (r < 4 * I_UP) { const int l = r / I_UP; p0_transpose_item(((const float*)Ap->w_up) + (size_t)l * 1024 * 5632, 1024, 5632, (bf16*)(ws + WS_WUP) + (size_t)l * 5632 * 1024, 0, ((const float*)Ap->pre_ffn_g) + l * 1024, 1.0f, 0, scr, r % I_UP, F.lane); continue; } r -= 4 * I_UP;
        if (r < 4 * I_DN) { const int l = r / I_DN; p0_transpose_item(((const float*)Ap->w_down) + (size_t)l * 2816 * 1024, 2816, 1024, (bf16*)(ws + WS_WDN) + (size_t)l * 1024 * 2816, 0, nullptr, 1.0f, 0, scr, r % I_DN, F.lane); continue; } r -= 4 * I_DN;
        if (r < 2 * I_DQ) { const int j = r / I_DQ; p0_transpose_item(((const float*)Ap->w_dq) + (size_t)j * 1024 * 512, 1024, 512, (bf16*)(ws + (j ? WS_WDQ1 : WS_WDQ0)), 0, ((const float*)Ap->pre_mix_g) + (2 + j) * 1024, 1.0f, 0, scr, r % I_DQ, F.lane); continue; } r -= 2 * I_DQ;
        if (r < I_DKV) { p0_transpose_item(((const float*)Ap->w_dkv), 1024, 320, (bf16*)(ws + WS_WDQ0), 512, ((const float*)Ap->kv_in_g), 1.0f, 0, scr, r, F.lane); continue; } r -= I_DKV;
        if (r < 2 * I_UQ) { const int j = r / I_UQ; p0_transpose_item(((const float*)Ap->w_uq) + (size_t)j * 512 * 1536, 512, 1536, (bf16*)(ws + WS_WUQ) + (size_t)j * 1536 * 512, 0, ((const float*)Ap->q_g) + j * 512, 0.07216878364870322f * LOG2E, 2, scr, r % I_UQ, F.lane); continue; } r -= 2 * I_UQ;
        if (r < 2 * I_KV) { const int j = r / I_KV; p0_transpose_item(j ? ((const float*)Ap->w_uv) : ((const float*)Ap->w_uk), 256, 1024, (bf16*)(ws + WS_WKV), j * 1024, nullptr, 1.0f, 0, scr, r % I_KV, F.lane); continue; } r -= 2 * I_KV;
        { const int j = r / I_O; p0_transpose_item(((const float*)Ap->w_o) + (size_t)j * 1024 * 1024, 1024, 1024, (bf16*)(ws + WS_WO) + (size_t)j * 1024 * 1024, 0, nullptr, 1.0f, 0, scr, r % I_O, F.lane); }
    }
    { const int gt = F.vcu * 512 + F.tid, NT = F.G * 512; GAS v4u* z = (GAS v4u*)(ws + WS_WDQ0 + (size_t)832 * 1024 * 2);
      for (int i = gt; i < 192 * 1024 * 2 / 16; i += NT) z[i] = (v4u){0u, 0u, 0u, 0u}; }
    { const int gt = F.vcu * 512 + F.tid, NT = F.G * 512; GAS unsigned* o = (GAS unsigned*)(ws + WS_WUKN);
      for (int i = gt; i < 256 * 1024 / 2; i += NT) o[i] = pk2(((const float*)Ap->w_uk)[2 * i], ((const float*)Ap->w_uk)[2 * i + 1]); }
    { const int gt = F.vcu * 512 + F.tid, NT = F.G * 512; GAS float* tab = (GAS float*)(ws + WS_ROPE);
      for (int i = gt; i < 2049 * 32; i += NT) { const int p = i >> 5, k = i & 31; const int pos = p == 2048 ? 8192 : p;
          const float inv = 1.0f / powf(10000.0f, (float)k / 32.0f); const float ang = (float)pos * inv; float sn, cs; sincosf(ang, &sn, &cs); tab[2 * i] = cs; tab[2 * i + 1] = sn; } }
    { GAS float* X = (GAS float*)(ws + WS_X); GAS float* RS = (GAS float*)(ws + WS_RSTD);
      for (int m = gw; m < MP; m += NGW) {
          const GAS f32x4* xr = (const GAS f32x4*)(((const float*)Ap->x_prompt) + (size_t)m * 1024) + F.lane; GAS f32x4* xo = (GAS f32x4*)(X + (size_t)m * 1024) + F.lane;
          GAS v2u* xb = (GAS v2u*)(ws + WS_XB + (size_t)m * 2048) + F.lane; float s = 0.f;
#pragma unroll
          for (int j = 0; j < 4; ++j) { const f32x4 v = xr[64 * j]; xo[64 * j] = v; s += (v.x * v.x + v.y * v.y) + (v.z * v.z + v.w * v.w); xb[64 * j] = (v2u){pk2(v.x, v.y), pk2(v.z, v.w)}; }
          s = wave_sum(s); if (F.lane == 0) RS[m] = rsqrtf(s * (1.0f / 1024.0f) + EPS); } }
}
__device__ __forceinline__ void thin_post(Frame& F, const float* MO, const float* SS, const float* gain, float* X, bf16* XB, float* RSTD, float* Y) {
    const int gw = F.vcu * NWAVES + F.wave, NGW = F.G * NWAVES;
    for (int m = gw; m < MP; m += NGW) {
        float ss = SS[(size_t)m * 16 + (F.lane & 15)]; ss += __shfl_xor(ss, 1); ss += __shfl_xor(ss, 2); ss += __shfl_xor(ss, 4); ss += __shfl_xor(ss, 8);
        const float rm = rsqrtf(ss * (1.0f / 1024.0f) + EPS);
        const GAS f32x4* mr = (const GAS f32x4*)(MO + (size_t)m * 1024) + F.lane; const GAS f32x4* gr = (const GAS f32x4*)gain + F.lane; GAS f32x4* xr = (GAS f32x4*)(X + (size_t)m * 1024) + F.lane;
        GAS v2u* xb = (GAS v2u*)(XB + (size_t)m * 1024) + F.lane; float s = 0.f;
#pragma unroll
        for (int j = 0; j < 4; ++j) { const f32x4 mv = mr[64 * j], g = gr[64 * j]; f32x4 x = xr[64 * j]; x = x + mv * rm * g; xr[64 * j] = x; if (Y) ((GAS f32x4*)(Y + (size_t)m * 1024) + F.lane)[64 * j] = x;
            s += (x.x * x.x + x.y * x.y) + (x.z * x.z + x.w * x.w); xb[64 * j] = (v2u){pk2(x.x, x.y), pk2(x.z, x.w)}; }
        s = wave_sum(s); if (F.lane == 0) RSTD[m] = rsqrtf(s * (1.0f / 1024.0f) + EPS);
    }
}
typedef short v4i16_t __attribute__((__vector_size__(4 * sizeof(short))));
__device__ __forceinline__ s16x4 tr_read(LAS unsigned char* p) { return __builtin_bit_cast(s16x4, __builtin_amdgcn_ds_read_tr16_b64_v4i16((LAS v4i16_t*)p)); }
__device__ __forceinline__ void sgu_phase(Frame& F, const bf16* U, const bf16* V, const float* VSS, const float* w_s, const float* b_s, const float* sgu_g, bf16* G2) {
    constexpr int WSM_OFF = 0, WSM_LD = 272, VT_OFF = 34816, VT_LD = 528, RS_OFF = 102400;
    LAS unsigned char* lds = F.lds; LAS float* RS = (LAS float*)(lds + RS_OFF);
    const int lane = F.lane, w = F.wave, q = lane >> 4, i16 = lane & 15;
    for (int unit = F.vcu; unit < 1024; unit += F.G) {
        const int chunk = unit >> 3, g = unit & 7, row0 = chunk * 128;
        __syncthreads();
        if (F.tid < 128) { const GAS f32x4* p = (const GAS f32x4*)(VSS + (size_t)(row0 + F.tid) * 32); float s = 0.f;
#pragma unroll
            for (int k = 0; k < 8; ++k) { const f32x4 v = p[k]; s += (v.x + v.y) + (v.z + v.w); }
            RS[F.tid] = rsqrtf(s * (1.0f / 2048.0f) + EPS); }
        __syncthreads();
#pragma unroll
        for (int k = 0; k < 8; ++k) { const int idx = F.tid + 512 * k, t = idx >> 5, s4 = (idx & 31) * 4; const f32x4 wv = *(const GAS f32x4*)(w_s + ((size_t)g * 128 + t) * 128 + s4);
            const float a0 = s4 + 0 <= t ? wv.x * RS[s4 + 0] : 0.f, a1 = s4 + 1 <= t ? wv.y * RS[s4 + 1] : 0.f, a2 = s4 + 2 <= t ? wv.z * RS[s4 + 2] : 0.f, a3 = s4 + 3 <= t ? wv.w * RS[s4 + 3] : 0.f;
            *(LAS v2u*)(lds + WSM_OFF + t * WSM_LD + s4 * 2) = (v2u){pk2(a0, a1), pk2(a2, a3)}; }
#pragma unroll
        for (int k = 0; k < 8; ++k) { const int idx = F.tid + 512 * k, s = idx >> 5, ch = idx & 31; const v4u vv = *(const GAS v4u*)(V + (size_t)(row0 + s) * 2048 + g * 256 + ch * 8);
            *(LAS v4u*)(lds + VT_OFF + s * VT_LD + ch * 16) = vv; }
        __syncthreads();
        f32x4 acc[8][2];
#pragma unroll
        for (int tb = 0; tb < 8; ++tb) { acc[tb][0] = (f32x4){0.f, 0.f, 0.f, 0.f}; acc[tb][1] = (f32x4){0.f, 0.f, 0.f, 0.f}; }
#pragma unroll
        for (int ks = 0; ks < 4; ++ks) {
            bf16x8 xf[2];
#pragma unroll
            for (int dbi = 0; dbi < 2; ++dbi) { LAS unsigned char* p = lds + VT_OFF + (32 * ks + 8 * q + (i16 >> 2)) * VT_LD + (16 * (2 * w + dbi) + 4 * (i16 & 3)) * 2;
                const s16x4 lo = tr_read(p), hi = tr_read(p + 4 * VT_LD); xf[dbi] = (bf16x8){lo[0], lo[1], lo[2], lo[3], hi[0], hi[1], hi[2], hi[3]}; }
#pragma unroll
            for (int tb = 2 * ks; tb < 8; ++tb) { const bf16x8 yf = *(const LAS bf16x8*)(lds + WSM_OFF + (16 * tb + i16) * WSM_LD + (32 * ks + 8 * q) * 2);
                acc[tb][0] = __builtin_amdgcn_mfma_f32_16x16x32_bf16(xf[0], yf, acc[tb][0], 0, 0, 0);
                acc[tb][1] = __builtin_amdgcn_mfma_f32_16x16x32_bf16(xf[1], yf, acc[tb][1], 0, 0, 0); }
        }
#pragma unroll
        for (int dbi = 0; dbi < 2; ++dbi) { const int d = g * 256 + 16 * (2 * w + dbi) + 4 * q; const f32x4 gg = *(const GAS f32x4*)(sgu_g + d);
#pragma unroll
            for (int tb = 0; tb < 8; ++tb) { const int t = 16 * tb + i16; const float bb = b_s[g * 128 + t]; const size_t off = (size_t)(row0 + t) * 2048 + d;
                const v2u uu = *(const GAS v2u*)(U + off); const f32x4 a = acc[tb][dbi];
                const float o0 = bflo(uu.x) * (a[0] * gg[0] + bb), o1 = bfhi(uu.x) * (a[1] * gg[1] + bb), o2 = bflo(uu.y) * (a[2] * gg[2] + bb), o3 = bfhi(uu.y) * (a[3] * gg[3] + bb);
                *(GAS v2u*)(G2 + off) = (v2u){pk2(o0, o1), pk2(o2, o3)}; } }
    }
    __syncthreads();
}
__device__ __forceinline__ float gelu_tanh_fast(float x) { const float u = 0.7978845608028654f * (x + 0.044715f * x * x * x); const float e = __builtin_amdgcn_exp2f(-2.0f * LOG2E * u); return x * __builtin_amdgcn_rcpf(1.0f + e); }
__device__ __forceinline__ void unpack8(const v4u v, float (&f)[8]) { f[0] = bflo(v.x); f[1] = bfhi(v.x); f[2] = bflo(v.y); f[3] = bfhi(v.y); f[4] = bflo(v.z); f[5] = bfhi(v.z); f[6] = bflo(v.w); f[7] = bfhi(v.w); }
__device__ __forceinline__ void conv_phase(Frame& F, const bf16* AB, const float* cw, const float* cb, bf16* GU) {
    const int gt = F.vcu * 512 + F.tid, NT = F.G * 512;
    for (int item = gt; item < 1024 * 352; item += NT) {
        const int rb = item / 352, jc = item % 352, j0 = jc * 8, r0 = rb * 16;
        float wg[3][8], wu[3][8], bg[8], bu[8];
#pragma unroll
        for (int k = 0; k < 3; ++k)
#pragma unroll
            for (int e = 0; e < 8; ++e) { wg[k][e] = cw[k * 5632 + j0 + e]; wu[k][e] = cw[k * 5632 + 2816 + j0 + e]; }
#pragma unroll
        for (int e = 0; e < 8; ++e) { bg[e] = cb[j0 + e]; bu[e] = cb[2816 + j0 + e]; }
        float g2[8], g1[8], u2[8], u1[8];
        if ((r0 & 2047) != 0) {
            unpack8(*(const GAS v4u*)(AB + (size_t)(r0 - 2) * 5632 + j0), g2); unpack8(*(const GAS v4u*)(AB + (size_t)(r0 - 1) * 5632 + j0), g1);
            unpack8(*(const GAS v4u*)(AB + (size_t)(r0 - 2) * 5632 + 2816 + j0), u2); unpack8(*(const GAS v4u*)(AB + (size_t)(r0 - 1) * 5632 + 2816 + j0), u1);
        } else {
#pragma unroll
            for (int e = 0; e < 8; ++e) { g2[e] = 0.f; g1[e] = 0.f; u2[e] = 0.f; u1[e] = 0.f; }
        }
#pragma unroll 1
        for (int i = 0; i < 16; ++i) {
            float g0[8], u0[8], o[8];
            unpack8(*(const GAS v4u*)(AB + (size_t)(r0 + i) * 5632 + j0), g0); unpack8(*(const GAS v4u*)(AB + (size_t)(r0 + i) * 5632 + 2816 + j0), u0);
#pragma unroll
            for (int e = 0; e < 8; ++e) { const float cg = bg[e] + wg[0][e] * g2[e] + wg[1][e] * g1[e] + wg[2][e] * g0[e]; const float cu = bu[e] + wu[0][e] * u2[e] + wu[1][e] * u1[e] + wu[2][e] * u0[e];
                o[e] = gelu_tanh_fast(cg) * cu; g2[e] = g1[e]; g1[e] = g0[e]; u2[e] = u1[e]; u1[e] = u0[e]; }
            *(GAS v4u*)(GU + (size_t)(r0 + i) * 2816 + j0) = (v4u){pk2(o[0], o[1]), pk2(o[2], o[3]), pk2(o[4], o[5]), pk2(o[6], o[7])};
        }
    }
}
__device__ __forceinline__ void kvfinal_phase(Frame& F, const float* KVR, const float* kv_g, const float* rope, float* out_ckv, float* out_kr, bf16* CKVB, bf16* KRB) {
    const int gw = F.vcu * NWAVES + F.wave, NGW = F.G * NWAVES, lane = F.lane;
    for (int m = gw; m < MP; m += NGW) {
        const float* r = KVR + (size_t)m * 320;
        const f32x4 v = *(const GAS f32x4*)(r + 4 * lane); const f32x4 g = *(const GAS f32x4*)(kv_g + 4 * lane);
        float s = (v.x * v.x + v.y * v.y) + (v.z * v.z + v.w * v.w); s = wave_sum(s);
        const float rs = rsqrtf(s * (1.0f / 256.0f) + EPS);
        const f32x4 o = v * rs * g;
        *(GAS f32x4*)(out_ckv + (size_t)m * 256 + 4 * lane) = o;
        *(GAS v2u*)(CKVB + (size_t)m * 256 + 4 * lane) = (v2u){pk2(o.x, o.y), pk2(o.z, o.w)};
        if (lane < 32) { const float x1 = r[256 + lane], x2 = r[288 + lane]; const int pos = m & 2047; const f32x2 cs = *(const GAS f32x2*)(rope + ((size_t)pos * 32 + lane) * 2);
            const float o1 = x1 * cs.x - x2 * cs.y, o2 = x2 * cs.x + x1 * cs.y;
            out_kr[(size_t)m * 64 + lane] = o1; out_kr[(size_t)m * 64 + 32 + lane] = o2;
            *(GAS unsigned*)(KRB + (size_t)m * 64 + 2 * lane) = pk2(o1, o2); }
    }
}
constexpr int AT_KLD = 400, AT_VLD = 136, AT_VOFF = 25600, AT_STAGE = 43008;
__device__ __forceinline__ void attn_phase(Frame& F, const bf16* Q, const bf16* KN, const bf16* KRB, const bf16* VT, bf16* OB) {
    const int lane = F.lane, w = F.wave, tid = F.tid, r32 = lane & 31, hh = lane >> 5;
    LAS unsigned char* lds = F.lds;
    for (int p = F.vcu; p < 256; p += F.G) {
#pragma unroll 1
        for (int half = 0; half < 2; ++half) {
            const int bh = p >> 2, sidx = p & 3, qb = half ? 7 - sidx : sidx, b = bh >> 3, h = bh & 7;
            const int q0 = 256 * qb + 32 * w; const int nt = 4 * (qb + 1);
            const GAS unsigned char* q_t = (const GAS unsigned char*)(Q + ((size_t)b * 2048 + 256 * qb) * 1536 + h * 192);
            asm volatile("" : "+s"(q_t));
            const unsigned qoff = (unsigned)(32 * w + r32) * 3072u + (unsigned)hh * 16u;
            bf16x8 qf[12];
#pragma unroll
            for (int ks = 0; ks < 12; ++ks) qf[ks] = *(const GAS bf16x8*)(q_t + qoff + 32 * ks);
            v4u kreg[3], vreg[2];
            const GAS unsigned char* kn_t = (const GAS unsigned char*)(KN + ((size_t)b * 2048) * 1024 + h * 128);
            const GAS unsigned char* kr_t = (const GAS unsigned char*)(KRB + ((size_t)b * 2048) * 64);
            const GAS unsigned char* vt_t = (const GAS unsigned char*)(VT + ((size_t)h * 128) * MP + (size_t)b * 2048);
#define AT_LOAD(j) do { \
                const GAS unsigned char* kb_ = kn_t + (size_t)(j) * (64 * 2048); const GAS unsigned char* rb_ = kr_t + (size_t)(j) * (64 * 128); const GAS unsigned char* vb_ = vt_t + (size_t)(j) * 128; \
                asm volatile("" : "+s"(kb_), "+s"(rb_), "+s"(vb_));     \
                _Pragma("unroll") for (int i = 0; i < 2; ++i) { const unsigned c = tid + 512 * i; kreg[i] = *(const GAS v4u*)(kb_ + ((c >> 4) * 2048u + (c & 15u) * 16u)); } \
                kreg[2] = *(const GAS v4u*)(rb_ + (((unsigned)tid >> 3) * 128u + ((unsigned)tid & 7u) * 16u)); \
                _Pragma("unroll") for (int i = 0; i < 2; ++i) { const unsigned c = tid + 512 * i; vreg[i] = *(const GAS v4u*)(vb_ + ((c >> 3) * (unsigned)(MP * 2) + (c & 7u) * 16u)); } } while (0)
#define AT_STORE(st) do { \
                _Pragma("unroll") for (int i = 0; i < 2; ++i) { const unsigned c = tid + 512 * i; *(LAS v4u*)((st) + (c >> 4) * AT_KLD + (c & 15u) * 16u) = kreg[i]; } \
                *(LAS v4u*)((st) + ((unsigned)tid >> 3) * AT_KLD + 256 + ((unsigned)tid & 7u) * 16u) = kreg[2]; \
                _Pragma("unroll") for (int i = 0; i < 2; ++i) { const unsigned c = tid + 512 * i; LAS unsigned char* vp_ = (st) + AT_VOFF + (c >> 3) * AT_VLD + (c & 7u) * 16u; \
                    *(LAS v2u*)vp_ = (v2u){vreg[i].x, vreg[i].y}; *(LAS v2u*)(vp_ + 8) = (v2u){vreg[i].z, vreg[i].w}; } } while (0)
            AT_LOAD(0);
            float m_run = -1.0e30f, l_run = 0.f;
            f32x16 O[4];
#pragma unroll
            for (int db = 0; db < 4; ++db)
#pragma unroll
                for (int e = 0; e < 16; ++e) O[db][e] = 0.f;
            __syncthreads();
#pragma unroll 1
            for (int j = 0; j < nt; ++j) {
                LAS unsigned char* st = lds + (j & 1) * AT_STAGE;
                AT_STORE(st);
                __syncthreads();
                if (j + 1 < nt) AT_LOAD(j + 1);
                if (64 * j > q0 + 31) continue;
                f32x16 S[2];
#pragma unroll
                for (int kb = 0; kb < 2; ++kb) {
#pragma unroll
                    for (int e = 0; e < 16; ++e) S[kb][e] = 0.f;
#pragma unroll
                    for (int ks = 0; ks < 12; ++ks) { const bf16x8 kf = *(const LAS bf16x8*)(st + (32 * kb + r32) * AT_KLD + (16 * ks + 8 * hh) * 2);
                        S[kb] = __builtin_amdgcn_mfma_f32_32x32x16_bf16(kf, qf[ks], S[kb], 0, 0, 0);
                        if ((ks & 3) == 3) asm volatile("" ::: "memory"); }
                }
                if (64 * j + 63 > q0) {
                    const int qa = q0 + r32;
#pragma unroll
                    for (int kb = 0; kb < 2; ++kb)
#pragma unroll
                        for (int e = 0; e < 16; ++e) { const int ka = 64 * j + 32 * kb + (e & 3) + 8 * (e >> 2) + 4 * hh; if (ka > qa) S[kb][e] = -1.0e30f; }
                }
                float mx = S[0][0];
#pragma unroll
                for (int kb = 0; kb < 2; ++kb)
#pragma unroll
                    for (int e = 0; e < 16; ++e) mx = fmaxf(mx, S[kb][e]);
                mx = fmaxf(mx, __shfl_xor(mx, 32));
                const float m_new = fmaxf(m_run, mx); const float alpha = __builtin_amdgcn_exp2f(m_run - m_new); m_run = m_new;
                float rsum = 0.f;
#pragma unroll
                for (int kb = 0; kb < 2; ++kb)
#pragma unroll
                    for (int e = 0; e < 16; ++e) { const float pv = __builtin_amdgcn_exp2f(S[kb][e] - m_new); S[kb][e] = pv; rsum += pv; }
                rsum += __shfl_xor(rsum, 32);
                l_run = l_run * alpha + rsum;
#pragma unroll
                for (int db = 0; db < 4; ++db)
#pragma unroll
                    for (int e = 0; e < 16; ++e) O[db][e] *= alpha;
                bf16x8 pf[2][2];
#pragma unroll
                for (int kb = 0; kb < 2; ++kb)
#pragma unroll
                    for (int s = 0; s < 2; ++s) { const unsigned a0 = pg8::cvt_pk_bf16(S[kb][8 * s + 0], S[kb][8 * s + 1]), a1 = pg8::cvt_pk_bf16(S[kb][8 * s + 2], S[kb][8 * s + 3]),
                                                                 a2 = pg8::cvt_pk_bf16(S[kb][8 * s + 4], S[kb][8 * s + 5]), a3 = pg8::cvt_pk_bf16(S[kb][8 * s + 6], S[kb][8 * s + 7]);
                        pf[kb][s] = __builtin_bit_cast(bf16x8, (v4u){a0, a1, a2, a3}); }
#pragma unroll
                for (int db = 0; db < 4; ++db)
#pragma unroll
                    for (int kb = 0; kb < 2; ++kb)
#pragma unroll
                        for (int s = 0; s < 2; ++s) { LAS unsigned char* vp = st + AT_VOFF + (32 * db + r32) * AT_VLD + (32 * kb + 16 * s + 4 * hh) * 2;
                            const v2u lo = *(const LAS v2u*)vp, hi = *(const LAS v2u*)(vp + 16);
                            const bf16x8 vf = __builtin_bit_cast(bf16x8, (v4u){lo.x, lo.y, hi.x, hi.y});
                            O[db] = __builtin_amdgcn_mfma_f32_32x32x16_bf16(vf, pf[kb][s], O[db], 0, 0, 0); if (kb == 1 && s == 1) asm volatile("" ::: "memory"); }
            }
            const float inv = 1.0f / l_run;
            GAS unsigned char* o_t = (GAS unsigned char*)(OB + ((size_t)b * 2048 + 256 * qb) * 1024 + h * 128); const unsigned ooff = (unsigned)(32 * w + r32) * 2048u; asm volatile("" : "+s"(o_t));
#pragma unroll
            for (int db = 0; db < 4; ++db)
#pragma unroll
                for (int g4 = 0; g4 < 4; ++g4) { const int d = 32 * db + 8 * g4 + 4 * hh;
                    *(GAS v2u*)(o_t + ooff + 2 * d) = (v2u){pk2(O[db][4 * g4 + 0] * inv, O[db][4 * g4 + 1] * inv), pk2(O[db][4 * g4 + 2] * inv, O[db][4 * g4 + 3] * inv)}; }
#undef AT_LOAD
#undef AT_STORE
        }
    }
    __syncthreads();
}
constexpr size_t WS_S0 = WS_FAST_END;
constexpr size_t WS_XS = WS_S0;
constexpr size_t WS_XSB = WS_XS + 512 * 1024;
constexpr size_t WS_RSTDS = WS_XSB + 256 * 1024;
constexpr size_t WS_SR = WS_RSTDS + 4096;
constexpr size_t WS_SRDQ = WS_SR + 128 * 5632 * 4;
constexpr size_t WS_SRUQ = WS_SRDQ + 128 * 832 * 4;
constexpr size_t WS_SQL = WS_SRUQ + 128 * 1536 * 4;
constexpr size_t WS_DQSS = WS_SQL + 128 * 2048 * 4;
constexpr size_t WS_SG2 = WS_DQSS + 128 * 64 * 4;
constexpr size_t WS_SGU = WS_SG2 + 128 * 2048 * 2;
constexpr size_t WS_SOL = WS_SGU + 128 * 2816 * 2;
constexpr size_t WS_SOB = WS_SOL + 128 * 2048 * 2;
constexpr int NSPLIT = 8;
constexpr size_t WS_PART = WS_SOB + 128 * 1024 * 2;
constexpr size_t WS_PM = WS_PART + (size_t)128 * NSPLIT * 8 * 256 * 4;
constexpr size_t WS_PL = WS_PM + 128 * NSPLIT * 8 * 4;
constexpr size_t WS_S_END = WS_PL + 128 * NSPLIT * 8 * 4;
static_assert(WS_S_END <= WS_NAIVE, "ws map (sample)");

template <bool AF32, bool OUTBF>
__device__ __forceinline__ void sgemm_phase(Frame& F, const void* Ap, int lda, size_t a_hs, const bf16* Btp, int ldb, size_t b_hs, int nheads, int Nh, int K, float* C, bf16* Cb, int ldc, size_t c_hs, float* ss, int ssld) {
    const int lane = F.lane, w = F.wave, i16 = lane & 15, q = lane >> 4, nks = K >> 5, uph = Nh >> 4;
    LAS float* red = (LAS float*)F.lds;
    for (int u = F.vcu; u < nheads * uph; u += F.G) {
        const int h = u / uph, n0 = 16 * (u % uph);
        const bf16* Bt = Btp + (size_t)h * b_hs + (size_t)(n0 + i16) * ldb + 8 * q;
        f32x4 acc[8];
#pragma unroll
        for (int m = 0; m < 8; ++m) acc[m] = (f32x4){0.f, 0.f, 0.f, 0.f};
        for (int ks = w; ks < nks; ks += 8) {
            const bf16x8 bfr = *(const GAS bf16x8*)(Bt + 32 * ks);
#pragma unroll
            for (int m = 0; m < 8; ++m) { bf16x8 afr;
                if (AF32) { const float* ap = (const float*)Ap + (size_t)h * a_hs + (size_t)(16 * m + i16) * lda + 32 * ks + 8 * q; const f32x4 x0 = *(const GAS f32x4*)ap, x1 = *(const GAS f32x4*)(ap + 4);
                    afr = __builtin_bit_cast(bf16x8, (v4u){pk2(x0.x, x0.y), pk2(x0.z, x0.w), pk2(x1.x, x1.y), pk2(x1.z, x1.w)}); }
                else afr = *(const GAS bf16x8*)((const bf16*)Ap + (size_t)h * a_hs + (size_t)(16 * m + i16) * lda + 32 * ks + 8 * q);
                acc[m] = __builtin_amdgcn_mfma_f32_16x16x32_bf16(bfr, afr, acc[m], 0, 0, 0); }
        }
        __syncthreads();
#pragma unroll
        for (int m = 0; m < 8; ++m) *(LAS f32x4*)(red + ((w * 128 + 16 * m + i16) * 16 + 4 * q)) = acc[m];
        __syncthreads();
        { const int row = F.tid >> 2, c4 = (F.tid & 3) * 4; f32x4 s = (f32x4){0.f, 0.f, 0.f, 0.f};
#pragma unroll
          for (int w2 = 0; w2 < 8; ++w2) s += *(const LAS f32x4*)(red + ((w2 * 128 + row) * 16 + c4));
          if (OUTBF) *(GAS v2u*)(Cb + (size_t)h * c_hs + (size_t)row * ldc + n0 + c4) = (v2u){pk2(s.x, s.y), pk2(s.z, s.w)};
          else *(GAS f32x4*)(C + (size_t)h * c_hs + (size_t)row * ldc + n0 + c4) = s;
          if (ss) { float sq = (s.x * s.x + s.y * s.y) + (s.z * s.z + s.w * s.w); sq += __shfl_xor(sq, 1); sq += __shfl_xor(sq, 2); if ((F.tid & 3) == 0) ss[(size_t)row * ssld + u] = sq; } }
    }
    __syncthreads();
}
__device__ __forceinline__ float block_sum512(Frame& F, float v, LAS float* red) {
    v = wave_sum(v); __syncthreads(); if (F.lane == 0) red[F.wave] = v; __syncthreads();
    return ((red[0] + red[1]) + (red[2] + red[3])) + ((red[4] + red[5]) + (red[6] + red[7]));
}
__device__ __forceinline__ float gelu_erf_f(float v) { return 0.5f * v * (1.0f + erff(v * 0.70710678118654752f)); }
__device__ __forceinline__ void s_rowA2(Frame& F, const float* SR, const float* RSTDS, const float* sgu_g, const float* w_s, const float* b_s, float* chunkv_out, bf16* SG2) {
    LAS float* ub = (LAS float*)F.lds; LAS float* red = ub + 2048;
    for (int row = F.vcu; row < MS; row += F.G) {
        const float rs = RSTDS[row]; const int c0 = 8 * F.tid; float z[8];
        { const f32x4 a = *(const GAS f32x4*)(SR + (size_t)row * 4096 + c0), b = *(const GAS f32x4*)(SR + (size_t)row * 4096 + c0 + 4);
          z[0] = gelu_erf_f(a.x * rs); z[1] = gelu_erf_f(a.y * rs); z[2] = gelu_erf_f(a.z * rs); z[3] = gelu_erf_f(a.w * rs); z[4] = gelu_erf_f(b.x * rs); z[5] = gelu_erf_f(b.y * rs); z[6] = gelu_erf_f(b.z * rs); z[7] = gelu_erf_f(b.w * rs); }
        float sq = 0.f;
        if (F.tid >= 256) {
#pragma unroll
            for (int e = 0; e < 8; ++e) sq += z[e] * z[e]; }
        else {
#pragma unroll
            for (int e = 0; e < 8; ++e) ub[c0 + e] = z[e]; }
        const float tot = block_sum512(F, sq, red);
        if (F.tid >= 256) { const float rv = rsqrtf(tot * (1.0f / 2048.0f) + EPS); const int cv = c0 - 2048, g = cv >> 8; const float wg = w_s[(size_t)g * 128 * 128], bg = b_s[g * 128]; float o[8];
#pragma unroll
            for (int e = 0; e < 8; ++e) { const float vn = z[e] * rv * sgu_g[cv + e]; chunkv_out[(size_t)row * 2048 + cv + e] = vn; o[e] = ub[cv + e] * (wg * vn + bg); }
            *(GAS v4u*)(SG2 + (size_t)row * 2048 + cv) = (v4u){pk2(o[0], o[1]), pk2(o[2], o[3]), pk2(o[4], o[5]), pk2(o[6], o[7])}; }
        __syncthreads();
    }
}
__device__ __forceinline__ void s_rowpost(Frame& F, const float* SR, const float* gain, float* XS, bf16* XSB, float* RSTDS, float* Y) {
    const int gw = F.vcu * NWAVES + F.wave, NGW = F.G * NWAVES;
    for (int m = gw; m < MS; m += NGW) {
        const GAS f32x4* mr = (const GAS f32x4*)(SR + (size_t)m * 1024) + F.lane; const GAS f32x4* gr = (const GAS f32x4*)gain + F.lane; GAS f32x4* xr = (GAS f32x4*)(XS + (size_t)m * 1024) + F.lane;
        f32x4 mv[4]; float ss = 0.f;
#pragma unroll
        for (int j = 0; j < 4; ++j) { mv[j] = mr[64 * j]; ss += (mv[j].x * mv[j].x + mv[j].y * mv[j].y) + (mv[j].z * mv[j].z + mv[j].w * mv[j].w); }
        const float rm = rsqrtf(wave_sum(ss) * (1.0f / 1024.0f) + EPS);
        GAS v2u* xb = (GAS v2u*)(XSB + (size_t)m * 1024) + F.lane; float s = 0.f;
#pragma unroll
        for (int j = 0; j < 4; ++j) { f32x4 x = xr[64 * j]; x = x + mv[j] * rm * gr[64 * j]; xr[64 * j] = x; if (Y) ((GAS f32x4*)(Y + (size_t)m * 1024) + F.lane)[64 * j] = x;
            s += (x.x * x.x + x.y * x.y) + (x.z * x.z + x.w * x.w); xb[64 * j] = (v2u){pk2(x.x, x.y), pk2(x.z, x.w)}; }
        s = wave_sum(s); if (F.lane == 0) RSTDS[m] = rsqrtf(s * (1.0f / 1024.0f) + EPS);
    }
}
__device__ __forceinline__ void s_rowconv(Frame& F, const float* SR, const float* RSTDS, const float* state  , const float* cw, const float* cb, float* conv_out  , bf16* SGUb) {
    for (int row = F.vcu; row < MS; row += F.G) {
        const float rs = RSTDS[row]; const float* s0 = state + (size_t)row * 2 * 5632; const float* s1 = s0 + 5632; const float* a = SR + (size_t)row * 5632; float* o0 = conv_out + (size_t)row * 2 * 5632; float* o1 = o0 + 5632;
        for (int j = F.tid; j < 2816; j += 512) {
            const float ag = a[j] * rs, au = a[j + 2816] * rs, p1g = s1[j], p1u = s1[j + 2816];
            o0[j] = p1g; o0[j + 2816] = p1u; o1[j] = ag; o1[j + 2816] = au;
            const float cg = cb[j] + s0[j] * cw[j] + p1g * cw[5632 + j] + ag * cw[2 * 5632 + j];
            const float cu = cb[j + 2816] + s0[j + 2816] * cw[j + 2816] + p1u * cw[5632 + j + 2816] + au * cw[2 * 5632 + j + 2816];
            SGUb[(size_t)row * 2816 + j] = (bf16)f2bf(gelu_tanh_fast(cg) * cu);
        }
    }
}
__device__ __forceinline__ float s_qscale(const float* RSTDS, const float* DQSS, int b) {
    const float rx = RSTDS[b]; float s = 0.f;
#pragma unroll
    for (int k = 0; k < 8; ++k) { const f32x4 v = *(const GAS f32x4*)(DQSS + (size_t)b * 64 + 4 * k); s += (v.x + v.y) + (v.z + v.w); }
    return rx * rsqrtf(rx * rx * s * (1.0f / 512.0f) + EPS);
}
constexpr int SA_LD = 656, SA_TILE = 16 * SA_LD;
__device__ __forceinline__ void sattn_phase(Frame& F, const float* SQL, const float* SRUQ, const float* RSTDS, const float* DQSS, const float* rope, const float* cache_ckv, const float* cache_kr, const int* page_table,
                                            float* PART, float* PM, float* PL) {
    const int lane = F.lane, w = F.wave, i16 = lane & 15, q = lane >> 4;
    LAS unsigned char* tile = F.lds + w * SA_TILE;
    for (int u = F.vcu; u < MS * NSPLIT; u += F.G) {
        const int b = u / NSPLIT, sp = u % NSPLIT;
        const float qs = s_qscale(RSTDS, DQSS, b);
        bf16x8 qf[10];
        if (i16 < 8) {
#pragma unroll
            for (int ks = 0; ks < 8; ++ks) { const float* p = SQL + ((size_t)b * 8 + i16) * 256 + 32 * ks + 8 * q; const f32x4 x0 = *(const GAS f32x4*)p * qs, x1 = *(const GAS f32x4*)(p + 4) * qs;
                qf[ks] = __builtin_bit_cast(bf16x8, (v4u){pk2(x0.x, x0.y), pk2(x0.z, x0.w), pk2(x1.x, x1.y), pk2(x1.z, x1.w)}); }
            const float* pp = SRUQ + (size_t)b * 1536 + i16 * 192 + 128 + 16 * q; float x1[8], x2[8], o1[8], o2[8];
            { const f32x4 a = *(const GAS f32x4*)pp, bb = *(const GAS f32x4*)(pp + 4), c = *(const GAS f32x4*)(pp + 8), d = *(const GAS f32x4*)(pp + 12);
              x1[0] = a.x; x2[0] = a.y; x1[1] = a.z; x2[1] = a.w; x1[2] = bb.x; x2[2] = bb.y; x1[3] = bb.z; x2[3] = bb.w; x1[4] = c.x; x2[4] = c.y; x1[5] = c.z; x2[5] = c.w; x1[6] = d.x; x2[6] = d.y; x1[7] = d.z; x2[7] = d.w; }
#pragma unroll
            for (int e = 0; e < 8; ++e) { const f32x2 cs = *(const GAS f32x2*)(rope + ((size_t)2048 * 32 + 8 * q + e) * 2); o1[e] = (x1[e] * cs.x - x2[e] * cs.y) * qs; o2[e] = (x2[e] * cs.x + x1[e] * cs.y) * qs; }
            qf[8] = __builtin_bit_cast(bf16x8, (v4u){pk2(o1[0], o1[1]), pk2(o1[2], o1[3]), pk2(o1[4], o1[5]), pk2(o1[6], o1[7])});
            qf[9] = __builtin_bit_cast(bf16x8, (v4u){pk2(o2[0], o2[1]), pk2(o2[2], o2[3]), pk2(o2[4], o2[5]), pk2(o2[6], o2[7])});
        } else {
#pragma unroll
            for (int ks = 0; ks < 10; ++ks) qf[ks] = (bf16x8){0, 0, 0, 0, 0, 0, 0, 0};
        }
        f32x4 raw[10][2];
#define SA_LOAD(gi) do { const int key0_ = sp * (PAST_LEN / NSPLIT) + 16 * (gi); const int page_ = page_table[b * NPAGES + (key0_ >> 7)]; const size_t slot_ = (size_t)page_ * PAGE + (key0_ & 127) + i16; \
            const float* cr_ = cache_ckv + slot_ * KV_LORA + 8 * q; const float* kr_ = cache_kr + slot_ * QK_ROPE + 8 * q; \
            _Pragma("unroll") for (int ks = 0; ks < 8; ++ks) { raw[ks][0] = *(const GAS f32x4*)(cr_ + 32 * ks); raw[ks][1] = *(const GAS f32x4*)(cr_ + 32 * ks + 4); } \
            _Pragma("unroll") for (int ks = 0; ks < 2; ++ks) { raw[8 + ks][0] = *(const GAS f32x4*)(kr_ + 32 * ks); raw[8 + ks][1] = *(const GAS f32x4*)(kr_ + 32 * ks + 4); } } while (0)
        SA_LOAD(w);
        float m_run = -1.0e30f, l_run = 0.f;
        f32x4 O[16];
#pragma unroll
        for (int cb = 0; cb < 16; ++cb) O[cb] = (f32x4){0.f, 0.f, 0.f, 0.f};
        __syncthreads();
#pragma unroll 1
        for (int i = 0; i < (PAST_LEN / NSPLIT / 16) / 8; ++i) {
#pragma unroll
            for (int ks = 0; ks < 10; ++ks) { const f32x4 x0 = raw[ks][0], x1 = raw[ks][1];
                *(LAS v4u*)(tile + i16 * SA_LD + (32 * ks + 8 * q) * 2) = (v4u){pk2(x0.x, x0.y), pk2(x0.z, x0.w), pk2(x1.x, x1.y), pk2(x1.z, x1.w)}; }
            if (i + 1 < (PAST_LEN / NSPLIT / 16) / 8) SA_LOAD(w + 8 * (i + 1));
            LDS_WAIT();
            f32x4 sacc = (f32x4){0.f, 0.f, 0.f, 0.f};
#pragma unroll
            for (int ks = 0; ks < 10; ++ks) { const bf16x8 kf = *(const LAS bf16x8*)(tile + i16 * SA_LD + (32 * ks + 8 * q) * 2); sacc = __builtin_amdgcn_mfma_f32_16x16x32_bf16(kf, qf[ks], sacc, 0, 0, 0); }
            float mx = fmaxf(fmaxf(sacc[0], sacc[1]), fmaxf(sacc[2], sacc[3])); mx = fmaxf(mx, __shfl_xor(mx, 16)); mx = fmaxf(mx, __shfl_xor(mx, 32));
            const float m_new = fmaxf(m_run, mx), alpha = __builtin_amdgcn_exp2f(m_run - m_new); m_run = m_new;
            const float p0 = __builtin_amdgcn_exp2f(sacc[0] - m_new), p1 = __builtin_amdgcn_exp2f(sacc[1] - m_new), p2 = __builtin_amdgcn_exp2f(sacc[2] - m_new), p3 = __builtin_amdgcn_exp2f(sacc[3] - m_new);
            float rsum = (p0 + p1) + (p2 + p3); rsum += __shfl_xor(rsum, 16); rsum += __shfl_xor(rsum, 32);
            l_run = l_run * alpha + rsum;
            const bf16x8 pf = __builtin_bit_cast(bf16x8, (v4u){pk2(p0, p1), pk2(p2, p3), 0u, 0u});
#pragma unroll
            for (int cb = 0; cb < 16; ++cb) { const s16x4 t4 = tr_read(tile + (4 * q + (i16 >> 2)) * SA_LD + (16 * cb + 4 * (i16 & 3)) * 2);
                const bf16x8 vf = (bf16x8){t4[0], t4[1], t4[2], t4[3], 0, 0, 0, 0};
                O[cb] = O[cb] * alpha; O[cb] = __builtin_amdgcn_mfma_f32_16x16x32_bf16(vf, pf, O[cb], 0, 0, 0); }
            LDS_WAIT();
        }
#undef SA_LOAD
        __syncthreads();
        { LAS float* Ob = (LAS float*)F.lds; LAS float* mb = (LAS float*)(F.lds + 65536); LAS float* lb = mb + 64;
          if (i16 < 8) {
#pragma unroll
              for (int cb = 0; cb < 16; ++cb) *(LAS f32x4*)(Ob + ((w * 8 + i16) * 256 + 16 * cb + 4 * q)) = O[cb];
              if (q == 0) { mb[w * 8 + i16] = m_run; lb[w * 8 + i16] = l_run; } }
          __syncthreads();
          const int hd = F.tid >> 6, c4 = (F.tid & 63) * 4; float M = mb[hd];
#pragma unroll
          for (int w2 = 1; w2 < 8; ++w2) M = fmaxf(M, mb[w2 * 8 + hd]);
          f32x4 acc = (f32x4){0.f, 0.f, 0.f, 0.f}; float L = 0.f;
#pragma unroll
          for (int w2 = 0; w2 < 8; ++w2) { const float sc = __builtin_amdgcn_exp2f(mb[w2 * 8 + hd] - M); acc += *(const LAS f32x4*)(Ob + ((w2 * 8 + hd) * 256 + c4)) * sc; L += lb[w2 * 8 + hd] * sc; }
          *(GAS f32x4*)(PART + ((size_t)u * 8 + hd) * 256 + c4) = acc;
          if ((F.tid & 63) == 0) { PM[(size_t)u * 8 + hd] = M; PL[(size_t)u * 8 + hd] = L; } }
    }
    __syncthreads();
}
__device__ __forceinline__ void scombine_phase(Frame& F, int first, const float* SRDQ, const float* SQL, const float* SRUQ, const float* RSTDS, const float* DQSS, const float* rope, const float* kv_g,
                                               const float* PART, const float* PM, const float* PL, float* out_ckv, float* out_kr, bf16* SOL) {
    LAS float* ckn = (LAS float*)F.lds; LAS float* krn = ckn + 256; LAS float* red = krn + 64;
    for (int b = F.vcu; b < MS; b += F.G) {
        __syncthreads();
        if (first) {
            const float rx = RSTDS[b]; float v = 0.f, sq = 0.f;
            if (F.tid < 256) { v = SRDQ[(size_t)b * 832 + 512 + F.tid] * rx; sq = v * v; }
            const float tot = block_sum512(F, sq, red);
            if (F.tid < 256) { const float o = v * rsqrtf(tot * (1.0f / 256.0f) + EPS) * kv_g[F.tid]; ckn[F.tid] = o; out_ckv[(size_t)b * 256 + F.tid] = o; }
            else if (F.tid < 288) { const int i = F.tid - 256; const float x1 = SRDQ[(size_t)b * 832 + 768 + i] * rx, x2 = SRDQ[(size_t)b * 832 + 800 + i] * rx; const f32x2 cs = *(const GAS f32x2*)(rope + ((size_t)2048 * 32 + i) * 2);
                const float o1 = x1 * cs.x - x2 * cs.y, o2 = x2 * cs.x + x1 * cs.y; krn[i] = o1; krn[32 + i] = o2; out_kr[(size_t)b * 64 + i] = o1; out_kr[(size_t)b * 64 + 32 + i] = o2; }
        } else {
            if (F.tid < 256) ckn[F.tid] = out_ckv[(size_t)b * 256 + F.tid]; else if (F.tid < 320) krn[F.tid - 256] = out_kr[(size_t)b * 64 + (F.tid - 256)];
        }
        __syncthreads();
        const float qs = s_qscale(RSTDS, DQSS, b);
        const int hd = F.wave, c4 = F.lane * 4;
        const f32x4 ql = *(const GAS f32x4*)(SQL + ((size_t)b * 8 + hd) * 256 + c4); const f32x4 cn = *(const LAS f32x4*)(ckn + c4);
        float dot = (ql.x * cn.x + ql.y * cn.y) + (ql.z * cn.z + ql.w * cn.w);
        if (F.lane < 32) { const float* pp = SRUQ + (size_t)b * 1536 + hd * 192 + 128; const float x1 = pp[2 * F.lane], x2 = pp[2 * F.lane + 1]; const f32x2 cs = *(const GAS f32x2*)(rope + ((size_t)2048 * 32 + F.lane) * 2);
            dot += (x1 * cs.x - x2 * cs.y) * krn[F.lane] + (x2 * cs.x + x1 * cs.y) * krn[32 + F.lane]; }
        const float sn = wave_sum(dot) * qs;
        float M = sn;
#pragma unroll
        for (int sp = 0; sp < NSPLIT; ++sp) M = fmaxf(M, PM[((size_t)b * NSPLIT + sp) * 8 + hd]);
        const float en = __builtin_amdgcn_exp2f(sn - M); float L = en; f32x4 acc = cn * en;
#pragma unroll
        for (int sp = 0; sp < NSPLIT; ++sp) { const size_t pi = ((size_t)b * NSPLIT + sp) * 8 + hd; const float sc = __builtin_amdgcn_exp2f(PM[pi] - M); L += PL[pi] * sc; acc += *(const GAS f32x4*)(PART + pi * 256 + c4) * sc; }
        const float inv = 1.0f / L;
        *(GAS v2u*)(SOL + ((size_t)b * 8 + hd) * 256 + c4) = (v2u){pk2(acc.x * inv, acc.y * inv), pk2(acc.z * inv, acc.w * inv)};
    }
    __syncthreads();
}
__device__ __forceinline__ void s_prologue(Frame& F, const float* x_sample, float* XS, bf16* XSB, float* RSTDS) {
    const int gw = F.vcu * NWAVES + F.wave, NGW = F.G * NWAVES;
    for (int m = gw; m < MS; m += NGW) {
        const GAS f32x4* xr = (const GAS f32x4*)(x_sample + (size_t)m * 1024) + F.lane; GAS f32x4* xo = (GAS f32x4*)(XS + (size_t)m * 1024) + F.lane; GAS v2u* xb = (GAS v2u*)(XSB + (size_t)m * 1024) + F.lane; float s = 0.f;
#pragma unroll
        for (int j = 0; j < 4; ++j) { const f32x4 v = xr[64 * j]; xo[64 * j] = v; s += (v.x * v.x + v.y * v.y) + (v.z * v.z + v.w * v.w); xb[64 * j] = (v2u){pk2(v.x, v.y), pk2(v.z, v.w)}; }
        s = wave_sum(s); if (F.lane == 0) RSTDS[m] = rsqrtf(s * (1.0f / 1024.0f) + EPS);
    }
}
constexpr int NPH_A = 8;
constexpr int NPH_FAST = 1 + 2 * NPH_A + 12 + 12;
#define X ((float*)(ws + WS_X))
#define XB ((bf16*)(ws + WS_XB))
#define RSTD ((float*)(ws + WS_RSTD))
#define U ((bf16*)(ws + WS_U))
#define V ((bf16*)(ws + WS_V))
#define VSS ((float*)(ws + WS_VSS))
#define G2 ((bf16*)(ws + WS_G2))
#define MO ((float*)(ws + WS_MO))
#define MSS ((float*)(ws + WS_MSS))
#define AB ((bf16*)(ws + WS_AB))
#define GU ((bf16*)(ws + WS_GU))
#define CQ ((bf16*)(ws + WS_CQ))
#define CQSS ((float*)(ws + WS_CQSS))
#define KVR ((float*)(ws + WS_KVR))
#define Qb ((bf16*)(ws + WS_Q))
#define CKVB ((bf16*)(ws + WS_CKVB))
#define KRB ((bf16*)(ws + WS_KRB))
#define KN ((bf16*)(ws + WS_KN))
#define VT ((bf16*)(ws + WS_VT))
#define OB ((bf16*)(ws + WS_OB))
#define ROPE ((const float*)(ws + WS_ROPE))
#define y_prompt ((float*)Ap->out)
#define y_sample ((float*)Ap->out + (size_t)MP * D_MODEL)
#define ckv_s (conv_p + (size_t)DEPTH * BATCH * 2 * FF2)
#define kr_s (ckv_s + (size_t)MS * KV_LORA)
#define conv_s (kr_s + (size_t)MS * QK_ROPE)
#define chunkv_s (conv_s + (size_t)DEPTH * MS * 2 * FF2)
#define XS ((float*)(ws + WS_XS))
#define XSB ((bf16*)(ws + WS_XSB))
#define RSTDS ((float*)(ws + WS_RSTDS))
#define SR ((float*)(ws + WS_SR))
#define SRDQ ((float*)(ws + WS_SRDQ))
#define SRUQ ((float*)(ws + WS_SRUQ))
#define SQL ((float*)(ws + WS_SQL))
#define DQSS ((float*)(ws + WS_DQSS))
#define SG2 ((bf16*)(ws + WS_SG2))
#define SGUB ((bf16*)(ws + WS_SGU))
#define SOL ((bf16*)(ws + WS_SOL))
#define SOB ((bf16*)(ws + WS_SOB))
#define PART ((float*)(ws + WS_PART))
#define PMx ((float*)(ws + WS_PM))
#define PLx ((float*)(ws + WS_PL))
#define ckv_p ((float*)Ap->out + (size_t)MP * D_MODEL + (size_t)MS * D_MODEL)
#define kr_p (ckv_p + (size_t)MP * KV_LORA)
#define conv_p (kr_p + (size_t)MP * QK_ROPE)

#define PHASE_BEGIN if (ph >= lo && ph < hi) { asm volatile("" : "+s"(Ap)); ws = Ap->ws; F.lane = pg8::lane_id_opaque(); F.tid = F.wave * 64 + F.lane;
#define RELANE() do { F.lane = pg8::lane_id_opaque(); F.tid = F.wave * 64 + F.lane; } while (0)
#define PHASE_END if (ph + 1 < hi) xcd_barrier(bar, F.tid == 0); } ++ph;
template <int LAYER> __device__ __forceinline__ void layer_phases(Frame& F, ArgsP& Ap, GAS unsigned char*& ws, const XcdBarrier& bar, int& ph, const int lo, const int hi) {
    constexpr int layer = LAYER;
#define SGEMM(AF, OB_, Ap, lda, ahs, Btp, ldb, bhs, nh, Nh, K, C, Cb, ldc, chs, ss, ssld) sgemm_phase<AF, OB_>(F, Ap, lda, ahs, Btp, ldb, bhs, nh, Nh, K, C, Cb, ldc, chs, ss, ssld)
    if (layer < 2) {
        PHASE_BEGIN {
            { pg8::Gemm g{XB, (const bf16*)(ws + WS_WIN) + (size_t)layer * 4096 * 1024, MP, 4096, 1024}; pg8::StaticOrder S; S.init(MP, 4096, F.G, (int)blockIdx.x);
              pg8::EpiZ E{U, V, RSTD, VSS};
              pg8::gemm_phase<pg8::EpiZ, pg8::StaticOrder, true, true>(F.lds + RING_OFF, g, S, E, F.wave); }
            RELANE(); SGEMM(false, false, XSB, 1024, 0, (const bf16*)(ws + WS_WIN) + (size_t)layer * 4096 * 1024, 1024, 0, 1, 4096, 1024, SR, nullptr, 4096, 0, nullptr, 0);
        } PHASE_END
        PHASE_BEGIN {
            sgu_phase(F, U, V, VSS, ((const float*)Ap->w_s) + (size_t)layer * 8 * 128 * 128, ((const float*)Ap->b_s) + (size_t)layer * 8 * 128, ((const float*)Ap->sgu_g) + (size_t)layer * 2048, G2);
            RELANE(); s_rowA2(F, SR, RSTDS, ((const float*)Ap->sgu_g) + (size_t)layer * 2048, ((const float*)Ap->w_s) + (size_t)layer * 8 * 128 * 128, ((const float*)Ap->b_s) + (size_t)layer * 8 * 128, chunkv_s + (size_t)layer * MS * 2048, SG2);
        } PHASE_END
        PHASE_BEGIN {
            { pg8::Gemm g{G2, (const bf16*)(ws + WS_WOUT) + (size_t)layer * 1024 * 2048, MP, 1024, 2048}; pg8::StaticOrder S; S.init(MP, 1024, F.G, (int)blockIdx.x);
              pg8::EpiF32SS E{MO, 1024, MSS, 16};
              pg8::gemm_phase<pg8::EpiF32SS, pg8::StaticOrder, true, true>(F.lds + RING_OFF, g, S, E, F.wave); }
            RELANE(); SGEMM(false, false, SG2, 2048, 0, (const bf16*)(ws + WS_WOUT) + (size_t)layer * 1024 * 2048, 2048, 0, 1, 1024, 2048, SR, nullptr, 1024, 0, nullptr, 0);
        } PHASE_END
        PHASE_BEGIN { thin_post(F, MO, MSS, ((const float*)Ap->post_mix_g) + layer * 1024, X, XB, RSTD, nullptr); RELANE(); s_rowpost(F, SR, ((const float*)Ap->post_mix_g) + layer * 1024, XS, XSB, RSTDS, nullptr); } PHASE_END
    } else {
        constexpr int j = layer - 2;
        PHASE_BEGIN {
            { pg8::Gemm g{XB, (const bf16*)(ws + (j ? WS_WDQ1 : WS_WDQ0)), MP, j ? 512 : 1024, 1024}; pg8::StaticOrder S; S.init(MP, j ? 512 : 1024, F.G, (int)blockIdx.x);
              pg8::EpiDq E{CQ, RSTD, CQSS, KVR};
              pg8::gemm_phase<pg8::EpiDq, pg8::StaticOrder, true, true>(F.lds + RING_OFF, g, S, E, F.wave); }
            RELANE(); SGEMM(false, false, XSB, 1024, 0, (const bf16*)(ws + (j ? WS_WDQ1 : WS_WDQ0)), 1024, 0, 1, j ? 512 : 832, 1024, SRDQ, nullptr, 832, 0, DQSS, 64);
        } PHASE_END
        PHASE_BEGIN {
            if (j == 0) kvfinal_phase(F, KVR, ((const float*)Ap->kv_g), ROPE, ckv_p, kr_p, CKVB, KRB);
            { pg8::Gemm g{CQ, (const bf16*)(ws + WS_WUQ) + (size_t)j * 1536 * 512, MP, 1536, 512}; pg8::StaticOrder S; S.init(MP, 1536, F.G, (int)blockIdx.x);
              pg8::EpiQ E{Qb, CQSS, ROPE};
              pg8::gemm_phase<pg8::EpiQ, pg8::StaticOrder, true, true>(F.lds + RING_OFF, g, S, E, F.wave); }
            RELANE(); SGEMM(true, false, SRDQ, 832, 0, (const bf16*)(ws + WS_WUQ) + (size_t)j * 1536 * 512, 512, 0, 1, 1536, 512, SRUQ, nullptr, 1536, 0, nullptr, 0);
        } PHASE_END
        PHASE_BEGIN {
            if (j == 0) {
                { pg8::Gemm g{CKVB, (const bf16*)(ws + WS_WKV), MP, 1024, 256}; pg8::StaticOrder S; S.init(MP, 1024, F.G, (int)blockIdx.x); pg8::EpiBf E{KN, 1024};
                  pg8::gemm_phase<pg8::EpiBf, pg8::StaticOrder, true, true>(F.lds + RING_OFF, g, S, E, F.wave); }
                { pg8::Gemm g{(const bf16*)(ws + WS_WKV) + (size_t)1024 * 256, CKVB, 1024, MP, 256}; pg8::StaticOrder S; S.init(1024, MP, F.G, (int)blockIdx.x); pg8::EpiBf E{VT, MP};
                  pg8::gemm_phase<pg8::EpiBf, pg8::StaticOrder, true, true>(F.lds + RING_OFF, g, S, E, F.wave); }
            }
            RELANE(); SGEMM(true, false, SRUQ, 1536, 192, (const bf16*)(ws + WS_WUKN), 1024, 128, 8, 256, 128, SQL, nullptr, 2048, 256, nullptr, 0);
        } PHASE_END
        PHASE_BEGIN {
            attn_phase(F, Qb, KN, KRB, VT, OB);
            RELANE(); sattn_phase(F, SQL, SRUQ, RSTDS, DQSS, ROPE, ((const float*)Ap->cache_ckv), ((const float*)Ap->cache_kr), ((const int*)Ap->page_table), PART, PMx, PLx);
        } PHASE_END
        PHASE_BEGIN {
            { pg8::Gemm g{OB, (const bf16*)(ws + WS_WO) + (size_t)j * 1024 * 1024, MP, 1024, 1024}; pg8::StaticOrder S; S.init(MP, 1024, F.G, (int)blockIdx.x);
              pg8::EpiF32SS E{MO, 1024, MSS, 16};
              pg8::gemm_phase<pg8::EpiF32SS, pg8::StaticOrder, true, true>(F.lds + RING_OFF, g, S, E, F.wave); }
            RELANE(); scombine_phase(F, j == 0, SRDQ, SQL, SRUQ, RSTDS, DQSS, ROPE, ((const float*)Ap->kv_g), PART, PMx, PLx, ckv_s, kr_s, SOL);
        } PHASE_END
        PHASE_BEGIN {
            thin_post(F, MO, MSS, ((const float*)Ap->post_mix_g) + layer * 1024, X, XB, RSTD, nullptr);
            RELANE(); SGEMM(false, true, SOL, 2048, 256, (const bf16*)(ws + WS_WKV) + (size_t)1024 * 256, 256, (size_t)128 * 256, 8, 128, 256, nullptr, SOB, 1024, 128, nullptr, 0);
        } PHASE_END
    }
    PHASE_BEGIN {
        { pg8::Gemm g{XB, (const bf16*)(ws + WS_WUP) + (size_t)layer * 5632 * 1024, MP, 5632, 1024}; pg8::StaticOrder S; S.init(MP, 5632, F.G, (int)blockIdx.x);
          pg8::EpiUp E{AB, RSTD, conv_p + (size_t)layer * 8 * 2 * 5632};
          pg8::gemm_phase<pg8::EpiUp, pg8::StaticOrder, true, true>(F.lds + RING_OFF, g, S, E, F.wave); }
        RELANE(); if (layer < 2) SGEMM(false, false, XSB, 1024, 0, (const bf16*)(ws + WS_WUP) + (size_t)layer * 5632 * 1024, 1024, 0, 1, 5632, 1024, SR, nullptr, 5632, 0, nullptr, 0);
        else SGEMM(false, false, SOB, 1024, 0, (const bf16*)(ws + WS_WO) + (size_t)(layer - 2) * 1024 * 1024, 1024, 0, 1, 1024, 1024, SR, nullptr, 1024, 0, nullptr, 0);
    } PHASE_END
    PHASE_BEGIN {
        conv_phase(F, AB, ((const float*)Ap->conv_w) + (size_t)layer * 3 * 5632, ((const float*)Ap->conv_b) + (size_t)layer * 5632, GU);
        RELANE(); if (layer < 2) s_rowconv(F, SR, RSTDS, ((const float*)Ap->state_conv) + (size_t)layer * MS * 2 * 5632, ((const float*)Ap->conv_w) + (size_t)layer * 3 * 5632, ((const float*)Ap->conv_b) + (size_t)layer * 5632, conv_s + (size_t)layer * MS * 2 * 5632, SGUB);
        else s_rowpost(F, SR, ((const float*)Ap->post_mix_g) + layer * 1024, XS, XSB, RSTDS, nullptr);
    } PHASE_END
    PHASE_BEGIN {
        { pg8::Gemm g{GU, (const bf16*)(ws + WS_WDN) + (size_t)layer * 1024 * 2816, MP, 1024, 2816}; pg8::StaticOrder S; S.init(MP, 1024, F.G, (int)blockIdx.x);
          pg8::EpiF32SS E{MO, 1024, MSS, 16};
          pg8::gemm_phase<pg8::EpiF32SS, pg8::StaticOrder, true, true>(F.lds + RING_OFF, g, S, E, F.wave); }
        RELANE(); if (layer < 2) SGEMM(false, false, SGUB, 2816, 0, (const bf16*)(ws + WS_WDN) + (size_t)layer * 1024 * 2816, 2816, 0, 1, 1024, 2816, SR, nullptr, 1024, 0, nullptr, 0);
        else SGEMM(false, false, XSB, 1024, 0, (const bf16*)(ws + WS_WUP) + (size_t)layer * 5632 * 1024, 1024, 0, 1, 5632, 1024, SR, nullptr, 5632, 0, nullptr, 0);
    } PHASE_END
    PHASE_BEGIN {
        thin_post(F, MO, MSS, ((const float*)Ap->post_ffn_g) + layer * 1024, X, XB, RSTD, layer == 3 ? y_prompt : nullptr);
        RELANE(); if (layer < 2) s_rowpost(F, SR, ((const float*)Ap->post_ffn_g) + layer * 1024, XS, XSB, RSTDS, nullptr);
        else s_rowconv(F, SR, RSTDS, ((const float*)Ap->state_conv) + (size_t)layer * MS * 2 * 5632, ((const float*)Ap->conv_w) + (size_t)layer * 3 * 5632, ((const float*)Ap->conv_b) + (size_t)layer * 5632, conv_s + (size_t)layer * MS * 2 * 5632, SGUB);
    } PHASE_END
    if (layer >= 2) {
        PHASE_BEGIN { SGEMM(false, false, SGUB, 2816, 0, (const bf16*)(ws + WS_WDN) + (size_t)layer * 1024 * 2816, 2816, 0, 1, 1024, 2816, SR, nullptr, 1024, 0, nullptr, 0); } PHASE_END
        PHASE_BEGIN { s_rowpost(F, SR, ((const float*)Ap->post_ffn_g) + layer * 1024, XS, XSB, RSTDS, layer == 3 ? y_sample : nullptr); } PHASE_END
    }
#undef SGEMM
}
__global__ void __launch_bounds__(NWAVES * 64, 2) fwd(Args A_) {
    extern __shared__ __attribute__((aligned(16))) unsigned char lds_raw[];
    Frame F;
    F.lds = (LAS unsigned char*)lds_raw;
    F.MISC = (volatile LAS unsigned*)(F.lds + MISC_OFF);
    F.tid = threadIdx.x; F.lane = F.tid & 63; F.wave = __builtin_amdgcn_readfirstlane(F.tid >> 6);
    F.G = gridDim.x; { const int bx = blockIdx.x; F.vcu = (F.G % 8 == 0) ? (bx % 8) * (F.G / 8) + bx / 8 : bx; }
    ArgsP Ap = (ArgsP)__builtin_amdgcn_kernarg_segment_ptr();
    GAS unsigned char* ws = Ap->ws;
    F.ctl = (gu32*)(ws + WS_CTL);
    for (int u = F.tid; u < (LDS_BYTES - LDSCTL_OFF) / 4; u += NWAVES * 64) ((LAS unsigned*)(F.lds + LDSCTL_OFF))[u] = 0u;
    __syncthreads();
    XcdBarrier bar = xcd_barrier_post((unsigned*)(F.ctl + CW_BAR), F.MISC + 8, F.tid == 0);
    const int lo = Ap->ph_lo, hi = Ap->ph_hi; int ph = 0;
    PHASE_BEGIN { p0_prologue(F, Ap); RELANE(); s_prologue(F, ((const float*)Ap->x_sample), XS, XSB, RSTDS); } PHASE_END
    layer_phases<0>(F, Ap, ws, bar, ph, lo, hi);
    layer_phases<1>(F, Ap, ws, bar, ph, lo, hi);
    layer_phases<2>(F, Ap, ws, bar, ph, lo, hi);
    layer_phases<3>(F, Ap, ws, bar, ph, lo, hi);
}
#undef PHASE_BEGIN
#undef PHASE_END
#undef X
#undef XB
#undef RSTD
#undef U
#undef V
#undef VSS
#undef G2
#undef MO
#undef MSS
#undef AB
#undef GU
#undef CQ
#undef CQSS
#undef KVR
#undef Qb
#undef CKVB
#undef KRB
#undef KN
#undef VT
#undef OB
#undef ROPE
#undef y_prompt
#undef y_sample
#undef ckv_s
#undef kr_s
#undef conv_s
#undef chunkv_s
#undef XS
#undef XSB
#undef RSTDS
#undef SR
#undef SRDQ
#undef SRUQ
#undef SQL
#undef DQSS
#undef SG2
#undef SGUB
#undef SOL
#undef SOB
#undef PART
#undef PMx
#undef PLx
#undef ckv_p
#undef kr_p
#undef conv_p

struct Ptrs {
    const float *x_prompt, *x_sample, *cache_ckv, *cache_kr, *state_conv; const int* page_table;
    const float *pre_mix_g, *post_mix_g, *pre_ffn_g, *post_ffn_g, *w_in_a, *sgu_g, *w_s, *b_s, *w_out_a, *kv_in_g, *w_dkv, *kv_g, *w_uk, *w_uv, *w_dq, *q_g, *w_uq, *w_o, *w_up, *conv_w, *conv_b, *w_down;
};
static void gemm(hipStream_t st, bool tb, const float* A, int lda, const float* B, int ldb, float* C, int ldc, int M, int N, int K, int accum = 0) {
    dim3 grid(N / 64, M / 64);
    if (tb) hipLaunchKernelGGL(nk_gemm<true>, grid, dim3(256), 0, st, A, lda, B, ldb, C, ldc, M, N, K, accum);
    else hipLaunchKernelGGL(nk_gemm<false>, grid, dim3(256), 0, st, A, lda, B, ldb, C, ldc, M, N, K, accum);
}
struct Bufs { float *X, *H, *Z, *G2, *MO, *A, *GU, *KV, *CKV, *KR, *CQ, *Q, *QL, *QP, *OL, *O, *S, *Ss; };

static void run_group_naive(hipStream_t st, const Ptrs& P, Bufs W, const float* xin, int nb, int T, int pos0, bool sample, int first_layer,
                            float* y, float* out_ckv, float* out_kr, float* out_conv, float* out_chunkv) {
    const int M = nb * T;
    W.CKV = out_ckv; W.KR = out_kr;
    if (first_layer == 0) (void)hipMemcpyAsync(W.X, xin, (size_t)M * D_MODEL * 4, hipMemcpyDeviceToDevice, st);
    const float scale = 1.0f / sqrtf((float)(QK_NOPE + QK_ROPE));
    for (int layer = first_layer; layer < DEPTH; ++layer) {
        if (layer == N_A) {
            hipLaunchKernelGGL(nk_rmsnorm, dim3(M), dim3(256), 0, st, W.X, D_MODEL, P.kv_in_g, W.H, D_MODEL, D_MODEL);
            gemm(st, false, W.H, D_MODEL, P.w_dkv, 320, W.KV, 320, M, 320, D_MODEL);
            hipLaunchKernelGGL(nk_rmsnorm, dim3(M), dim3(256), 0, st, W.KV, 320, P.kv_g, W.CKV, KV_LORA, KV_LORA);
            hipLaunchKernelGGL(nk_rope, dim3(1024), dim3(256), 0, st, W.KV, 320, 256, 0, 1, W.KR, 64, 0, 0, M, T, pos0);
        }
        hipLaunchKernelGGL(nk_rmsnorm, dim3(M), dim3(256), 0, st, W.X, D_MODEL, P.pre_mix_g + layer * D_MODEL, W.H, D_MODEL, D_MODEL);
        if (layer < N_A) {
            gemm(st, false, W.H, D_MODEL, P.w_in_a + (size_t)layer * D_MODEL * 4096, 4096, W.Z, 4096, M, 4096, D_MODEL);
            hipLaunchKernelGGL(nk_gelu_exact, dim3(2048), dim3(256), 0, st, W.Z, (size_t)M * 4096);
            hipLaunchKernelGGL(nk_rmsnorm, dim3(M), dim3(256), 0, st, W.Z + 2048, 4096, P.sgu_g + layer * 2048, W.Z + 2048, 4096, 2048);
            if (sample) hipLaunchKernelGGL(nk_copy2d, dim3(256), dim3(256), 0, st, W.Z + 2048, 4096, out_chunkv + (size_t)layer * M * 2048, 2048, M, 2048);
            const int cl = T >= CHUNK ? CHUNK : T;
            hipLaunchKernelGGL(nk_sgu, dim3(M / cl, 8), dim3(256), 0, st, W.Z, P.w_s + (size_t)layer * 8 * CHUNK * CHUNK, P.b_s + (size_t)layer * 8 * CHUNK, W.G2, cl);
            gemm(st, false, W.G2, 2048, P.w_out_a + (size_t)layer * 2048 * D_MODEL, D_MODEL, W.MO, D_MODEL, M, D_MODEL, 2048);
        } else {
            const int j = layer - N_A;
            gemm(st, false, W.H, D_MODEL, P.w_dq + (size_t)j * D_MODEL * Q_LORA, Q_LORA, W.Q  , Q_LORA, M, Q_LORA, D_MODEL);
            hipLaunchKernelGGL(nk_rmsnorm, dim3(M), dim3(256), 0, st, W.Q, Q_LORA, P.q_g + j * Q_LORA, W.CQ, Q_LORA, Q_LORA);
            gemm(st, false, W.CQ, Q_LORA, P.w_uq + (size_t)j * Q_LORA * 1536, 1536, W.Q, 1536, M, 1536, Q_LORA);
            hipLaunchKernelGGL(nk_rope, dim3(1024), dim3(256), 0, st, W.Q, 1536, 128, 192, 8, W.QP, 512, 0, 64, M, T, pos0);
            for (int h = 0; h < NH; ++h) gemm(st, true, W.Q + h * 192, 1536, P.w_uk + h * 128, 1024, W.QL + h * 256, 2048, M, 256, 128);
            if (!sample) {
                for (int b = 0; b < nb; ++b) for (int h = 0; h < NH; ++h) {
                    gemm(st, true, W.QL + (size_t)b * T * 2048 + h * 256, 2048, W.CKV + (size_t)b * T * 256, 256, W.S, T, T, T, 256, 0);
                    gemm(st, true, W.QP + (size_t)b * T * 512 + h * 64, 512, W.KR + (size_t)b * T * 64, 64, W.S, T, T, T, 64, 1);
                    hipLaunchKernelGGL(nk_softmax_causal, dim3(T), dim3(256), 0, st, W.S, T, scale);
                    gemm(st, false, W.S, T, W.CKV + (size_t)b * T * 256, 256, W.OL + (size_t)b * T * 2048 + h * 256, 2048, T, 256, T, 0);
                }
            } else {
                hipLaunchKernelGGL(nk_sattn_scores, dim3(MS), dim3(256), 0, st, W.QL, W.QP, P.cache_ckv, P.cache_kr, P.page_table, W.CKV, W.KR, W.Ss, scale);
                hipLaunchKernelGGL(nk_sattn_softmax, dim3(MS * 8), dim3(256), 0, st, W.Ss);
                hipLaunchKernelGGL(nk_sattn_pv, dim3(MS), dim3(256), 0, st, W.Ss, P.cache_ckv, P.page_table, W.CKV, W.OL);
            }
            for (int h = 0; h < NH; ++h) gemm(st, false, W.OL + h * 256, 2048, P.w_uv + h * 128, 1024, W.O + h * 128, 1024, M, 128, 256);
            gemm(st, false, W.O, 1024, P.w_o + (size_t)j * 1024 * 1024, 1024, W.MO, 1024, M, 1024, 1024);
        }
        hipLaunchKernelGGL(nk_resid_rmsnorm, dim3(M), dim3(256), 0, st, W.X, W.MO, P.post_mix_g + layer * D_MODEL, D_MODEL);
        hipLaunchKernelGGL(nk_rmsnorm, dim3(M), dim3(256), 0, st, W.X, D_MODEL, P.pre_ffn_g + layer * D_MODEL, W.H, D_MODEL, D_MODEL);
        gemm(st, false, W.H, D_MODEL, P.w_up + (size_t)layer * D_MODEL * FF2, FF2, W.A, FF2, M, FF2, D_MODEL);
        hipLaunchKernelGGL(nk_conv_gate, dim3(4096), dim3(256), 0, st, W.A, sample ? P.state_conv + (size_t)layer * nb * 2 * FF2 : (const float*)nullptr,
                           P.conv_w + (size_t)layer * 3 * FF2, P.conv_b + (size_t)layer * FF2, W.GU, out_conv + (size_t)layer * nb * 2 * FF2, nb, T);
        gemm(st, false, W.GU, D_FF, P.w_down + (size_t)layer * D_FF * D_MODEL, D_MODEL, W.MO, D_MODEL, M, D_MODEL, D_FF);
        hipLaunchKernelGGL(nk_resid_rmsnorm, dim3(M), dim3(256), 0, st, W.X, W.MO, P.post_ffn_g + layer * D_MODEL, D_MODEL);
    }
    (void)hipMemcpyAsync(y, W.X, (size_t)M * D_MODEL * 4, hipMemcpyDeviceToDevice, st);
}

extern "C" void kernel_launch(void* const* d_in, const int* in_sizes, int n_in, void* d_out, int out_size, void* d_ws, size_t ws_size, hipStream_t stream) {
    Ptrs P;
    P.x_prompt = (const float*)d_in[0]; P.x_sample = (const float*)d_in[1]; P.cache_ckv = (const float*)d_in[2]; P.cache_kr = (const float*)d_in[3]; P.state_conv = (const float*)d_in[4];
    P.page_table = (const int*)d_in[5]; P.pre_mix_g = (const float*)d_in[6]; P.post_mix_g = (const float*)d_in[7]; P.pre_ffn_g = (const float*)d_in[8]; P.post_ffn_g = (const float*)d_in[9];
    P.w_in_a = (const float*)d_in[10]; P.sgu_g = (const float*)d_in[11]; P.w_s = (const float*)d_in[12]; P.b_s = (const float*)d_in[13]; P.w_out_a = (const float*)d_in[14];
    P.kv_in_g = (const float*)d_in[15]; P.w_dkv = (const float*)d_in[16]; P.kv_g = (const float*)d_in[17]; P.w_uk = (const float*)d_in[18]; P.w_uv = (const float*)d_in[19];
    P.w_dq = (const float*)d_in[20]; P.q_g = (const float*)d_in[21]; P.w_uq = (const float*)d_in[22]; P.w_o = (const float*)d_in[23]; P.w_up = (const float*)d_in[24];
    P.conv_w = (const float*)d_in[25]; P.conv_b = (const float*)d_in[26]; P.w_down = (const float*)d_in[27];

    float* out = (float*)d_out;
    float* y_prompt = out; float* y_sample = y_prompt + (size_t)MP * D_MODEL; float* ckv_p = y_sample + (size_t)MS * D_MODEL; float* kr_p = ckv_p + (size_t)MP * KV_LORA;
    float* conv_p = kr_p + (size_t)MP * QK_ROPE; float* ckv_s = conv_p + (size_t)DEPTH * BATCH * 2 * FF2; float* kr_s = ckv_s + (size_t)MS * KV_LORA;
    float* conv_s = kr_s + (size_t)MS * QK_ROPE; float* chunkv_s = conv_s + (size_t)DEPTH * MS * 2 * FF2;

    static int grid = 0;
    if (grid == 0) {
        int dev = 0, cus = 0;
        if (hipGetDevice(&dev) != hipSuccess || hipDeviceGetAttribute(&cus, hipDeviceAttributeMultiprocessorCount, dev) != hipSuccess) { fprintf(stderr, "kernel_launch: device query failed\n"); grid = -1; return; }
        if (hipFuncSetAttribute((const void*)fwd, hipFuncAttributeMaxDynamicSharedMemorySize, LDS_BYTES) != hipSuccess) { fprintf(stderr, "kernel_launch: hipFuncSetAttribute failed\n"); grid = -1; return; }
        (void)hipGetLastError();
        grid = cus;
    }
    if (grid < 0) return;

    float* w = (float*)((unsigned char*)d_ws + WS_NAIVE); size_t off = 0;
    auto take = [&](size_t n) { float* p = w + off; off += (n + 63) & ~(size_t)63; return p; };
    Bufs W;
    W.X = take((size_t)MP * 1024); W.H = take((size_t)MP * 1024); W.Z = take((size_t)MP * 4096); W.G2 = take((size_t)MP * 2048); W.MO = take((size_t)MP * 1024);
    W.A = take((size_t)MP * FF2); W.GU = take((size_t)MP * D_FF); W.KV = take((size_t)MP * 320); W.CKV = nullptr; W.KR = nullptr;
    W.CQ = take((size_t)MP * 512); W.Q = take((size_t)MP * 1536); W.QL = take((size_t)MP * 2048); W.QP = take((size_t)MP * 512); W.OL = take((size_t)MP * 2048);
    W.O = take((size_t)MP * 1024); W.S = take((size_t)SEQ * SEQ); W.Ss = take((size_t)MS * 8 * SLD);
    if (WS_NAIVE + off * 4 > ws_size) { fprintf(stderr, "workspace too small: need %zu have %zu\n", WS_NAIVE + off * 4, ws_size); return; }

    (void)hipMemsetAsync((char*)d_ws + WS_CTL, 0, CTL_ZERO_BYTES, stream);
    Args a{};
    a.x_prompt = (decltype(a.x_prompt))P.x_prompt; a.x_sample = (decltype(a.x_sample))P.x_sample; a.cache_ckv = (decltype(a.cache_ckv))P.cache_ckv; a.cache_kr = (decltype(a.cache_kr))P.cache_kr; a.state_conv = (decltype(a.state_conv))P.state_conv; a.page_table = (decltype(a.page_table))P.page_table;
    a.pre_mix_g = (decltype(a.pre_mix_g))P.pre_mix_g; a.post_mix_g = (decltype(a.post_mix_g))P.post_mix_g; a.pre_ffn_g = (decltype(a.pre_ffn_g))P.pre_ffn_g; a.post_ffn_g = (decltype(a.post_ffn_g))P.post_ffn_g; a.w_in_a = (decltype(a.w_in_a))P.w_in_a; a.sgu_g = (decltype(a.sgu_g))P.sgu_g; a.w_s = (decltype(a.w_s))P.w_s; a.b_s = (decltype(a.b_s))P.b_s;
    a.w_out_a = (decltype(a.w_out_a))P.w_out_a; a.kv_in_g = (decltype(a.kv_in_g))P.kv_in_g; a.w_dkv = (decltype(a.w_dkv))P.w_dkv; a.kv_g = (decltype(a.kv_g))P.kv_g; a.w_uk = (decltype(a.w_uk))P.w_uk; a.w_uv = (decltype(a.w_uv))P.w_uv; a.w_dq = (decltype(a.w_dq))P.w_dq; a.q_g = (decltype(a.q_g))P.q_g; a.w_uq = (decltype(a.w_uq))P.w_uq; a.w_o = (decltype(a.w_o))P.w_o;
    a.w_up = (decltype(a.w_up))P.w_up; a.conv_w = (decltype(a.conv_w))P.conv_w; a.conv_b = (decltype(a.conv_b))P.conv_b; a.w_down = (decltype(a.w_down))P.w_down; a.out = (GAS float*)out; a.ws = (GAS unsigned char*)d_ws;
#ifndef MK_PER_PHASE
    a.ph_lo = 0; a.ph_hi = NPH_FAST; hipLaunchKernelGGL(fwd, dim3(grid), dim3(NWAVES * 64), LDS_BYTES, stream, a);
#else
    for (int ph = 0; ph < NPH_FAST; ++ph) { a.ph_lo = ph; a.ph_hi = ph + 1; hipLaunchKernelGGL(fwd, dim3(grid), dim3(NWAVES * 64), LDS_BYTES, stream, a); }
#endif
    { const hipError_t le = hipPeekAtLastError(); if (le != hipSuccess) fprintf(stderr, "kernel_launch: launch failed: %s\n", hipGetErrorName(le)); }

}
```

```cpp
#include <hip/hip_runtime.h>
#include <cstdio>
#include <cstdint>

constexpr int D_MODEL = 1024, BATCH = 8, SEQ = 2048, DEPTH = 4, DEC_BATCH = 128, PAST_LEN = 8192, PAGE = 128;
constexpr int N_A = 2, CHUNK = 128, SGU_W = 2048, SGU_G = 8, SGU_GD = 256;
constexpr int NH = 8, QK_NOPE = 128, QK_ROPE = 64, V_HEAD = 128, Q_LORA = 512, KV_LORA = 256;
constexpr int D_FF = 2816, FF2 = 5632;
constexpr float EPS = 1e-6f;
constexpr int MP = BATCH * SEQ;
constexpr int MS = DEC_BATCH;
constexpr int NPAGES = PAST_LEN / PAGE;

__device__ __forceinline__ float block_sum_256(float v, float* red) {
    for (int o = 32; o >= 1; o >>= 1) v += __shfl_xor(v, o);
    const int w = threadIdx.x >> 6;
    __syncthreads();
    if ((threadIdx.x & 63) == 0) red[w] = v;
    __syncthreads();
    float s = red[0] + red[1] + red[2] + red[3];
    return s;
}
__device__ __forceinline__ float block_max_256(float v, float* red) {
    for (int o = 32; o >= 1; o >>= 1) v = fmaxf(v, __shfl_xor(v, o));
    const int w = threadIdx.x >> 6;
    __syncthreads();
    if ((threadIdx.x & 63) == 0) red[w] = v;
    __syncthreads();
    return fmaxf(fmaxf(red[0], red[1]), fmaxf(red[2], red[3]));
}

__global__ void __launch_bounds__(256) nk_rmsnorm(const float* in, int ldi, const float* g, float* out, int ldo, int D) {
    __shared__ float red[4];
    const float* r = in + (size_t)blockIdx.x * ldi; float* o = out + (size_t)blockIdx.x * ldo;
    float s = 0.f;
    for (int i = threadIdx.x; i < D; i += 256) { const float v = r[i]; s += v * v; }
    s = block_sum_256(s, red);
    const float rstd = rsqrtf(s / (float)D + EPS);
    for (int i = threadIdx.x; i < D; i += 256) o[i] = r[i] * rstd * g[i];
}
__global__ void __launch_bounds__(256) nk_resid_rmsnorm(float* x, const float* m, const float* g, int D) {
    __shared__ float red[4];
    const float* r = m + (size_t)blockIdx.x * D; float* o = x + (size_t)blockIdx.x * D;
    float s = 0.f;
    for (int i = threadIdx.x; i < D; i += 256) { const float v = r[i]; s += v * v; }
    s = block_sum_256(s, red);
    const float rstd = rsqrtf(s / (float)D + EPS);
    for (int i = threadIdx.x; i < D; i += 256) o[i] += r[i] * rstd * g[i];
}

template <bool TB>
__global__ void __launch_bounds__(256) nk_gemm(const float* __restrict__ A, int lda, const float* __restrict__ B, int ldb, float* C, int ldc, int M, int N, int K, int accum) {
    __shared__ float As[16][65];
    __shared__ float Bs[16][65];
    const int tx = threadIdx.x & 15, ty = threadIdx.x >> 4;
    const int m0 = blockIdx.y * 64, n0 = blockIdx.x * 64;
    float acc[4][4];
#pragma unroll
    for (int i = 0; i < 4; ++i)
#pragma unroll
        for (int j = 0; j < 4; ++j) acc[i][j] = 0.f;
    for (int k0 = 0; k0 < K; k0 += 16) {
#pragma unroll
        for (int i = 0; i < 4; ++i) { const int idx = threadIdx.x + i * 256; const int r = idx >> 4, c = idx & 15; As[c][r] = A[(size_t)(m0 + r) * lda + k0 + c]; }
        if (TB) {
#pragma unroll
            for (int i = 0; i < 4; ++i) { const int idx = threadIdx.x + i * 256; const int r = idx >> 4, c = idx & 15; Bs[c][r] = B[(size_t)(n0 + r) * ldb + k0 + c]; }
        } else {
#pragma unroll
            for (int i = 0; i < 4; ++i) { const int idx = threadIdx.x + i * 256; const int r = idx >> 6, c = idx & 63; Bs[r][c] = B[(size_t)(k0 + r) * ldb + n0 + c]; }
        }
        __syncthreads();
#pragma unroll
        for (int kk = 0; kk < 16; ++kk) {
            float a[4], b[4];
#pragma unroll
            for (int i = 0; i < 4; ++i) { a[i] = As[kk][ty * 4 + i]; b[i] = Bs[kk][tx * 4 + i]; }
#pragma unroll
            for (int i = 0; i < 4; ++i)
#pragma unroll
                for (int j = 0; j < 4; ++j) acc[i][j] += a[i] * b[j];
        }
        __syncthreads();
    }
#pragma unroll
    for (int i = 0; i < 4; ++i)
#pragma unroll
        for (int j = 0; j < 4; ++j) { float* p = C + (size_t)(m0 + ty * 4 + i) * ldc + n0 + tx * 4 + j; *p = accum ? (*p + acc[i][j]) : acc[i][j]; }
}

__global__ void nk_gelu_exact(float* z, size_t n) {
    for (size_t i = (size_t)blockIdx.x * blockDim.x + threadIdx.x; i < n; i += (size_t)gridDim.x * blockDim.x) { const float v = z[i]; z[i] = 0.5f * v * (1.0f + erff(v * 0.70710678118654752f)); }
}

__global__ void __launch_bounds__(256) nk_sgu(const float* Z, const float* ws_, const float* bs_, float* G2, int cl) {
    const int chunk = blockIdx.x, g = blockIdx.y, d = threadIdx.x;
    const float* w = ws_ + (size_t)g * CHUNK * CHUNK; const float* b = bs_ + (size_t)g * CHUNK;
    for (int t = 0; t < cl; ++t) {
        float acc = 0.f;
        for (int s = 0; s <= t; ++s) acc += w[t * CHUNK + s] * Z[(size_t)(chunk * cl + s) * 4096 + 2048 + g * 256 + d];
        acc += b[t];
        const size_t row = (size_t)(chunk * cl + t);
        G2[row * 2048 + g * 256 + d] = Z[row * 4096 + g * 256 + d] * acc;
    }
}

__device__ __forceinline__ float gelu_tanh_f(float x) { const float u = 0.7978845608028654f * (x + 0.044715f * x * x * x); return 0.5f * x * (1.0f + tanhf(u)); }
__global__ void nk_conv_gate(const float* A, const float* prev, const float* cw, const float* cb, float* GU, float* newconv, int nb, int T) {
    const size_t total = (size_t)nb * T * D_FF;
    for (size_t i = (size_t)blockIdx.x * blockDim.x + threadIdx.x; i < total; i += (size_t)gridDim.x * blockDim.x) {
        const int j = (int)(i % D_FF); const size_t row = i / D_FF; const int t = (int)(row % T), b = (int)(row / T);
        float c2[2];
#pragma unroll
        for (int half = 0; half < 2; ++half) {
            const int col = j + half * D_FF; float c = cb[col];
#pragma unroll
            for (int k = 0; k < 3; ++k) { const int tt = t + k - 2; float v;
                if (tt >= 0) v = A[((size_t)b * T + tt) * FF2 + col]; else v = prev ? prev[((size_t)b * 2 + (tt + 2)) * FF2 + col] : 0.f;
                c += v * cw[k * FF2 + col]; }
            c2[half] = c; }
        GU[row * D_FF + j] = gelu_tanh_f(c2[0]) * c2[1];
    }
    const size_t tot2 = (size_t)nb * 2 * FF2;
    for (size_t i = (size_t)blockIdx.x * blockDim.x + threadIdx.x; i < tot2; i += (size_t)gridDim.x * blockDim.x) {
        const int col = (int)(i % FF2); const int r = (int)((i / FF2) % 2); const int b = (int)(i / (2 * FF2));
        const int tt = T - 2 + r; float v;
        if (tt >= 0) v = A[((size_t)b * T + tt) * FF2 + col]; else v = prev ? prev[((size_t)b * 2 + (tt + 2)) * FF2 + col] : 0.f;
        newconv[i] = v;
    }
}

__global__ void nk_rope(const float* X, int ldx, int col0, int cstride, int nblk, float* Y, int ldy, int ycol0, int ycstride, int M, int T, int pos0) {
    const size_t total = (size_t)M * nblk * 32;
    for (size_t i = (size_t)blockIdx.x * blockDim.x + threadIdx.x; i < total; i += (size_t)gridDim.x * blockDim.x) {
        const int k = (int)(i % 32); const int blk = (int)((i / 32) % nblk); const size_t row = i / (32 * nblk);
        const int pos = pos0 + (int)(row % T);
        const float inv = 1.0f / powf(10000.0f, (float)k / 32.0f);
        const float ang = (float)pos * inv;
        float sn, cs; sincosf(ang, &sn, &cs);
        const float x1 = X[row * ldx + col0 + blk * cstride + k], x2 = X[row * ldx + col0 + blk * cstride + k + 32];
        Y[row * ldy + ycol0 + blk * ycstride + k] = x1 * cs - x2 * sn;
        Y[row * ldy + ycol0 + blk * ycstride + k + 32] = x2 * cs + x1 * sn;
    }
}
__global__ void nk_copy2d(const float* X, int ldx, float* Y, int ldy, int rows, int cols) {
    const size_t total = (size_t)rows * cols;
    for (size_t i = (size_t)blockIdx.x * blockDim.x + threadIdx.x; i < total; i += (size_t)gridDim.x * blockDim.x) { const size_t r = i / cols; const int c = (int)(i % cols); Y[r * ldy + c] = X[r * ldx + c]; }
}
__global__ void __launch_bounds__(256) nk_softmax_causal(float* S, int T, float scale) {
    __shared__ float red[4];
    const int t = blockIdx.x; float* r = S + (size_t)t * T;
    float mx = -3.0e38f;
    for (int s = threadIdx.x; s <= t; s += 256) mx = fmaxf(mx, r[s] * scale);
    mx = block_max_256(mx, red);
    float sum = 0.f;
    for (int s = threadIdx.x; s < T; s += 256) { float p = 0.f; if (s <= t) p = __expf(r[s] * scale - mx); r[s] = p; sum += p; }
    sum = block_sum_256(sum, red);
    const float inv = 1.0f / sum;
    for (int s = threadIdx.x; s <= t; s += 256) r[s] *= inv;
}

constexpr int SKEYS = PAST_LEN + 1, SLD = 8200;
__global__ void __launch_bounds__(256) nk_sattn_scores(const float* QL, const float* QP, const float* cache_ckv, const float* cache_kr, const int* page_table, const float* CKVn, const float* KRn, float* Ss, float scale) {
    __shared__ float q[8][320];
    const int b = blockIdx.x;
    for (int i = threadIdx.x; i < 8 * 320; i += 256) { const int h = i / 320, c = i % 320; q[h][c] = c < 256 ? QL[((size_t)b * 8 + h) * 256 + c] : QP[((size_t)b * 8 + h) * 64 + (c - 256)]; }
    __syncthreads();
    for (int key = threadIdx.x; key < SKEYS; key += 256) {
        const float *cr, *kr;
        if (key < PAST_LEN) { const int page = page_table[b * NPAGES + key / PAGE]; const size_t slot = (size_t)page * PAGE + (key % PAGE); cr = cache_ckv + slot * KV_LORA; kr = cache_kr + slot * QK_ROPE; }
        else { cr = CKVn + (size_t)b * KV_LORA; kr = KRn + (size_t)b * QK_ROPE; }
        float acc[8];
#pragma unroll
        for (int h = 0; h < 8; ++h) acc[h] = 0.f;
        for (int c = 0; c < 256; ++c) { const float kv = cr[c];
#pragma unroll
            for (int h = 0; h < 8; ++h) acc[h] += q[h][c] * kv; }
        for (int c = 0; c < 64; ++c) { const float kv = kr[c];
#pragma unroll
            for (int h = 0; h < 8; ++h) acc[h] += q[h][256 + c] * kv; }
#pragma unroll
        for (int h = 0; h < 8; ++h) Ss[((size_t)b * 8 + h) * SLD + key] = acc[h] * scale;
    }
}
__global__ void __launch_bounds__(256) nk_sattn_softmax(float* Ss) {
    __shared__ float red[4];
    float* r = Ss + (size_t)blockIdx.x * SLD;
    float mx = -3.0e38f;
    for (int s = threadIdx.x; s < SKEYS; s += 256) mx = fmaxf(mx, r[s]);
    mx = block_max_256(mx, red);
    float sum = 0.f;
    for (int s = threadIdx.x; s < SKEYS; s += 256) { const float p = __expf(r[s] - mx); r[s] = p; sum += p; }
    sum = block_sum_256(sum, red);
    const float inv = 1.0f / sum;
    for (int s = threadIdx.x; s < SKEYS; s += 256) r[s] *= inv;
}
__global__ void __launch_bounds__(256) nk_sattn_pv(const float* Ss, const float* cache_ckv, const int* page_table, const float* CKVn, float* OL) {
    const int b = blockIdx.x, c = threadIdx.x;
    float acc[8];
#pragma unroll
    for (int h = 0; h < 8; ++h) acc[h] = 0.f;
    for (int key = 0; key < SKEYS; ++key) {
        const float* cr;
        if (key < PAST_LEN) { const int page = page_table[b * NPAGES + key / PAGE]; cr = cache_ckv + ((size_t)page * PAGE + (key % PAGE)) * KV_LORA; } else cr = CKVn + (size_t)b * KV_LORA;
        const float v = cr[c];
#pragma unroll
        for (int h = 0; h < 8; ++h) acc[h] += Ss[((size_t)b * 8 + h) * SLD + key] * v;
    }
#pragma unroll
    for (int h = 0; h < 8; ++h) OL[((size_t)b * 8 + h) * 256 + c] = acc[h];
}

namespace pg8 {
#define PG8_LAS __attribute__((address_space(3)))
typedef unsigned short bf16_t;
typedef short bf16x8 __attribute__((ext_vector_type(8)));
typedef float f32x4 __attribute__((ext_vector_type(4)));
typedef unsigned u32x4 __attribute__((ext_vector_type(4)));
constexpr int BM = 256, BK = 64, HALF = 128, HTB = HALF * BK * 2  , STAGE_BYTES = 8 * HTB, NXCD = 8, WGM = 8;

__host__ __device__ __forceinline__ int lds_byte(int r, int c) { const int st = (r >> 4) * 2 + (c >> 5), rr = r & 15, cc = c & 31, ob = rr * 64 + cc * 2; return st * 1024 + (ob ^ (((ob >> 9) & 1) << 5)); }
__host__ __device__ __forceinline__ void stage_rc(int b, int& R, int& C) { const int st = b / 1024, sb = b % 1024, swz = sb ^ (((sb >> 9) & 1) << 5); R = (st >> 1) * 16 + swz / 64; C = (st & 1) * 32 + (swz % 64) / 2; }
__host__ __device__ __forceinline__ int perm32(int rho) { const int n = rho >> 4, i = rho & 15; return 8 * (i >> 2) + 4 * n + (i & 3); }

__device__ __forceinline__ int lane_id_opaque() { int l; asm volatile("v_mbcnt_lo_u32_b32 %0, -1, 0\n\tv_mbcnt_hi_u32_b32 %0, -1, %0" : "=v"(l)); return l; }
struct Unit { int pm, pn; };
struct Gemm { const bf16_t* A; const bf16_t* Bt; int M, N, K; };

struct StaticOrder {
    int nM, nN, nwg, G, c;
    __host__ __device__ void init(int M, int N, int G_, int c_) { nM = M / BM; nN = N / BM; nwg = nM * nN; G = G_; c = c_; }
    __host__ __device__ bool next(int i, Unit& u) const {
        const long L = (long)i * G + c; if (L >= nwg) return false;
        int wgid = (int)L; { const int q = nwg / NXCD, r = nwg % NXCD, xcd = wgid % NXCD, off = wgid / NXCD; wgid = (xcd < r ? xcd * (q + 1) : r * (q + 1) + (xcd - r) * q) + off; }
        const int nig = WGM * nN, gid = wgid / nig, fm = gid * WGM, gsz = (nM - fm) < WGM ? (nM - fm) : WGM;
        u.pm = fm + ((wgid % nig) % gsz); u.pn = (wgid % nig) / gsz; return true;
    }
    __device__ __forceinline__ void a_ready(const Unit&) const {}
    __device__ __forceinline__ void done(const Unit&) const {}
};

__device__ __forceinline__ unsigned cvt_pk_bf16(float lo, float hi) { unsigned r; asm volatile("v_cvt_pk_bf16_f32 %0, %1, %2" : "=v"(r) : "v"(lo), "v"(hi)); return r; }
typedef float f32x2 __attribute__((ext_vector_type(2)));
__device__ __forceinline__ f32x2 gelu_pk(f32x2 v) {
    const f32x2 av = __builtin_elementwise_abs(v), d = av * 0.2316418882f + 1.0f;
    f32x2 t; t.x = __builtin_amdgcn_rcpf(d.x); t.y = __builtin_amdgcn_rcpf(d.y);
    f32x2 q = t * 0.5307027145f + (-0.7265760135f); q = q * t + 0.7107068705f; q = q * t + (-0.142248368f); q = q * t + 0.127414796f; q = q * t;
    const f32x2 s = (v * v) * (-0.72134752044f);
    f32x2 e; e.x = __builtin_amdgcn_exp2f(s.x); e.y = __builtin_amdgcn_exp2f(s.y);
    const f32x2 m = v * (q * e), r = v - m;
    f32x2 o; o.x = v.x < 0.f ? m.x : r.x; o.y = v.y < 0.f ? m.y : r.y; return o;
}

__device__ __forceinline__ float half_reduce_fq(float s) { s += __shfl_xor(s, 16); s += __shfl_xor(s, 32); return s; }
struct EpiF32SS {
    static constexpr bool PERM = false, AFTER_DRAIN = false;
    float* C; int ldc; float* ss; int ssld;
    __device__ __forceinline__ void operator()(const f32x4 (&acc)[2][2][4][2], const Unit& u, int wr, int wc, int fr, int fq) const {
        const int row0 = u.pm * BM + wr * 64 + fr, col0 = u.pn * BM + wc * 32 + 4 * fq;
#pragma unroll
        for (int ai = 0; ai < 2; ++ai)
#pragma unroll
            for (int m = 0; m < 4; ++m) { const int row = row0 + ai * HALF + m * 16; float* rowp = C + (size_t)row * ldc + col0; float s = 0.f;
#pragma unroll
                for (int bj = 0; bj < 2; ++bj)
#pragma unroll
                    for (int n = 0; n < 2; ++n) { const f32x4 v = acc[ai][bj][m][n]; *(f32x4*)(rowp + bj * HALF + n * 16) = v; s += (v[0] * v[0] + v[1] * v[1]) + (v[2] * v[2] + v[3] * v[3]); }
                s = half_reduce_fq(s);
                if (fq == 0) ss[(size_t)row * ssld + u.pn * 4 + wc] = s; }
    }
};
struct EpiZ {
    static constexpr bool PERM = true, AFTER_DRAIN = false;
    bf16_t* U; bf16_t* V; const float* rstd; float* vss;
    __device__ __forceinline__ void operator()(const f32x4 (&acc)[2][2][4][2], const Unit& u, int wr, int wc, int fr, int fq) const {
        const int row0 = u.pm * BM + wr * 64 + fr; const bool isv = u.pn >= 8; bf16_t* base = isv ? V : U; const int col0 = (u.pn & 7) * BM + wc * 32 + 8 * fq;
#pragma unroll
        for (int ai = 0; ai < 2; ++ai)
#pragma unroll
            for (int m = 0; m < 4; ++m) { const int row = row0 + ai * HALF + m * 16; const float rs = rstd[row]; bf16_t* rowp = base + (size_t)row * 2048 + col0; float s = 0.f;
#pragma unroll
                for (int bj = 0; bj < 2; ++bj) { f32x4 v0 = acc[ai][bj][m][0] * rs, v1 = acc[ai][bj][m][1] * rs;
                    { f32x2 a = gelu_pk((f32x2){v0[0], v0[1]}), b = gelu_pk((f32x2){v0[2], v0[3]}), c = gelu_pk((f32x2){v1[0], v1[1]}), d = gelu_pk((f32x2){v1[2], v1[3]});
                      v0 = (f32x4){a.x, a.y, b.x, b.y}; v1 = (f32x4){c.x, c.y, d.x, d.y}; }
                    s += (v0[0] * v0[0] + v0[1] * v0[1]) + (v0[2] * v0[2] + v0[3] * v0[3]) + (v1[0] * v1[0] + v1[1] * v1[1]) + (v1[2] * v1[2] + v1[3] * v1[3]);
                    u32x4 w; w.x = cvt_pk_bf16(v0[0], v0[1]); w.y = cvt_pk_bf16(v0[2], v0[3]); w.z = cvt_pk_bf16(v1[0], v1[1]); w.w = cvt_pk_bf16(v1[2], v1[3]);
                    *(u32x4*)(rowp + bj * HALF) = w; }
                if (isv) { s = half_reduce_fq(s); if (fq == 0) vss[(size_t)row * 32 + (u.pn - 8) * 4 + wc] = s; } }
    }
};
template <int CTRL> __device__ __forceinline__ float dppf(float old, float src) { return __builtin_bit_cast(float, __builtin_amdgcn_update_dpp(__builtin_bit_cast(int, old), __builtin_bit_cast(int, src), CTRL, 0xf, 0xf, false)); }
__device__ __forceinline__ float row_prev1(float cur, float prevblk) { return dppf<0x111>(dppf<0x121>(0.f, prevblk), cur); }
__device__ __forceinline__ float row_prev2(float cur, float prevblk) { return dppf<0x112>(dppf<0x122>(0.f, prevblk), cur); }
__device__ __forceinline__ float gelu_tanh_e(float x) { const float uu = 0.7978845608028654f * (x + 0.044715f * x * x * x); const float e = __builtin_amdgcn_exp2f(-2.8853900817779268f * uu); return x * __builtin_amdgcn_rcpf(1.0f + e); }
struct EpiUpConv {
    static constexpr bool PERM = true, AFTER_DRAIN = false;
    bf16_t* GU; const float* rstd; const float* cw; const float* cb; float* conv_out; float* halo; PG8_LAS unsigned char* xl;
    __device__ __forceinline__ void operator()(const f32x4 (&acc)[2][2][4][2], const Unit& u, int wr, int wc, int fr, int fq) const {
        const int row0 = u.pm * BM + wr * 64 + fr; const int cl = wc * 32 + 8 * fq;
        float rs[2][4];
#pragma unroll
        for (int ai = 0; ai < 2; ++ai)
#pragma unroll
            for (int m = 0; m < 4; ++m) rs[ai][m] = rstd[row0 + ai * HALF + m * 16];
        PG8_LAS f32x4* XL = (PG8_LAS f32x4*)xl;
        if (fr >= 14) {
#pragma unroll
            for (int ai = 0; ai < 2; ++ai) { const int slot = ai * 2 + wr;
#pragma unroll
                for (int bj = 0; bj < 2; ++bj)
#pragma unroll
                    for (int n = 0; n < 2; ++n) { const f32x4 v = acc[ai][bj][3][n] * rs[ai][3];
                        if (slot < 3) XL[((slot * 4 + wc) * 2 + (fr - 14)) * 16 + (bj * 2 + n) * 4 + fq] = v;
                        else *(f32x4*)(halo + ((size_t)u.pm * 4 + 2 + (fr - 14)) * 5632 + bj * 2816 + u.pn * 128 + cl + 4 * n) = v; } }
        }
        if (wr == 0 && fr < 2) {
#pragma unroll
            for (int bj = 0; bj < 2; ++bj)
#pragma unroll
                for (int n = 0; n < 2; ++n) *(f32x4*)(halo + ((size_t)u.pm * 4 + fr) * 5632 + bj * 2816 + u.pn * 128 + cl + 4 * n) = acc[0][bj][0][n] * rs[0][0];
        }
        asm volatile("s_waitcnt lgkmcnt(0)" ::: "memory"); __builtin_amdgcn_s_barrier(); asm volatile("" ::: "memory");
#pragma unroll
        for (int n = 0; n < 2; ++n) {
            const int gcol = u.pn * 128 + cl + 4 * n;
            const f32x4 wg0 = *(const f32x4*)(cw + gcol), wg1 = *(const f32x4*)(cw + 5632 + gcol), wg2 = *(const f32x4*)(cw + 2 * 5632 + gcol), bg = *(const f32x4*)(cb + gcol);
            const f32x4 wu0 = *(const f32x4*)(cw + 2816 + gcol), wu1 = *(const f32x4*)(cw + 5632 + 2816 + gcol), wu2 = *(const f32x4*)(cw + 2 * 5632 + 2816 + gcol), bu = *(const f32x4*)(cb + 2816 + gcol);
#pragma unroll
            for (int ai = 0; ai < 2; ++ai) {
                f32x4 pg = (f32x4){0.f, 0.f, 0.f, 0.f}, pu = (f32x4){0.f, 0.f, 0.f, 0.f};
                if (ai * 2 + wr > 0) { const int ps = ai * 2 + wr - 1; const int b0 = ((ps * 4 + wc) * 2) * 16 + fq;
                    const f32x4 g0 = XL[b0 + n * 4], g1 = XL[b0 + 16 + n * 4], u0 = XL[b0 + (2 + n) * 4], u1 = XL[b0 + 16 + (2 + n) * 4];
                    pg = fr == 15 ? g1 : g0; pu = fr == 15 ? u1 : u0; }
#pragma unroll
                for (int m = 0; m < 4; ++m) { const int row = row0 + ai * HALF + m * 16; const f32x4 cg = acc[ai][0][m][n] * rs[ai][m], cu = acc[ai][1][m][n] * rs[ai][m]; float o[4];
#pragma unroll
                    for (int i = 0; i < 4; ++i) { const float vg = bg[i] + wg0[i] * row_prev2(cg[i], pg[i]) + wg1[i] * row_prev1(cg[i], pg[i]) + wg2[i] * cg[i];
                        const float vu = bu[i] + wu0[i] * row_prev2(cu[i], pu[i]) + wu1[i] * row_prev1(cu[i], pu[i]) + wu2[i] * cu[i]; o[i] = gelu_tanh_e(vg) * vu; }
                    typedef unsigned u32x2 __attribute__((ext_vector_type(2)));
                    *(u32x2*)(GU + (size_t)row * 2816 + gcol) = (u32x2){cvt_pk_bf16(o[0], o[1]), cvt_pk_bf16(o[2], o[3])};
                    const int t = row & 2047;
                    if (t >= 2046) { float* co = conv_out + ((size_t)(row >> 11) * 2 + (t - 2046)) * 5632 + gcol; *(f32x4*)co = cg; *(f32x4*)(co + 2816) = cu; }
                    pg = cg; pu = cu; }
            }
        }
    }
};
struct EpiDq {
    static constexpr bool PERM = true, AFTER_DRAIN = false;
    bf16_t* CQ; const float* rstd; float* cqss; float* KVR;
    __device__ __forceinline__ void operator()(const f32x4 (&acc)[2][2][4][2], const Unit& u, int wr, int wc, int fr, int fq) const {
        const int row0 = u.pm * BM + wr * 64 + fr, col0 = u.pn * BM + wc * 32 + 8 * fq; const bool iscq = u.pn < 2;
#pragma unroll
        for (int ai = 0; ai < 2; ++ai)
#pragma unroll
            for (int m = 0; m < 4; ++m) { const int row = row0 + ai * HALF + m * 16; const float rs = rstd[row]; float s = 0.f;
#pragma unroll
                for (int bj = 0; bj < 2; ++bj) { const f32x4 v0 = acc[ai][bj][m][0] * rs, v1 = acc[ai][bj][m][1] * rs; const int c = col0 + bj * HALF;
                    if (iscq) { s += (v0[0] * v0[0] + v0[1] * v0[1]) + (v0[2] * v0[2] + v0[3] * v0[3]) + (v1[0] * v1[0] + v1[1] * v1[1]) + (v1[2] * v1[2] + v1[3] * v1[3]);
                        u32x4 w; w.x = cvt_pk_bf16(v0[0], v0[1]); w.y = cvt_pk_bf16(v0[2], v0[3]); w.z = cvt_pk_bf16(v1[0], v1[1]); w.w = cvt_pk_bf16(v1[2], v1[3]);
                        *(u32x4*)(CQ + (size_t)row * 512 + c) = w; }
                    else if (c - 512 < 320) { float* o = KVR + (size_t)row * 320 + (c - 512); *(f32x4*)o = v0; *(f32x4*)(o + 4) = v1; } }
                if (iscq) { s = half_reduce_fq(s); if (fq == 0) cqss[(size_t)row * 8 + u.pn * 4 + wc] = s; } }
    }
};
struct EpiQ {
    static constexpr bool PERM = true, AFTER_DRAIN = false;
    bf16_t* Q; const float* cqss; const float* rope;
    __device__ __forceinline__ void operator()(const f32x4 (&acc)[2][2][4][2], const Unit& u, int wr, int wc, int fr, int fq) const {
        const int row0 = u.pm * BM + wr * 64 + fr, col0 = u.pn * BM + wc * 32 + 8 * fq;
#pragma unroll
        for (int ai = 0; ai < 2; ++ai)
#pragma unroll
            for (int m = 0; m < 4; ++m) { const int row = row0 + ai * HALF + m * 16; const f32x4 p0 = *(const f32x4*)(cqss + (size_t)row * 8), p1 = *(const f32x4*)(cqss + (size_t)row * 8 + 4);
                const float rs = rsqrtf(((p0[0] + p0[1]) + (p0[2] + p0[3]) + (p1[0] + p1[1]) + (p1[2] + p1[3])) * (1.0f / 512.0f) + 1e-6f); const int pos = row & 2047;
#pragma unroll
                for (int bj = 0; bj < 2; ++bj) { f32x4 v0 = acc[ai][bj][m][0] * rs, v1 = acc[ai][bj][m][1] * rs; const int c = col0 + bj * HALF; const int cin = c % 192;
                    if (cin >= 128) { const int i0 = (cin - 128) >> 1; const f32x4 t0 = *(const f32x4*)(rope + ((size_t)pos * 32 + i0) * 2), t1 = *(const f32x4*)(rope + ((size_t)pos * 32 + i0 + 2) * 2);
                        const f32x4 a = v0, b = v1;
                        v0[0] = a[0] * t0[0] - a[1] * t0[1]; v0[1] = a[1] * t0[0] + a[0] * t0[1]; v0[2] = a[2] * t0[2] - a[3] * t0[3]; v0[3] = a[3] * t0[2] + a[2] * t0[3];
                        v1[0] = b[0] * t1[0] - b[1] * t1[1]; v1[1] = b[1] * t1[0] + b[0] * t1[1]; v1[2] = b[2] * t1[2] - b[3] * t1[3]; v1[3] = b[3] * t1[2] + b[2] * t1[3]; }
                    u32x4 w; w.x = cvt_pk_bf16(v0[0], v0[1]); w.y = cvt_pk_bf16(v0[2], v0[3]); w.z = cvt_pk_bf16(v1[0], v1[1]); w.w = cvt_pk_bf16(v1[2], v1[3]);
                    *(u32x4*)(Q + (size_t)row * 1536 + c) = w; } }
    }
};
struct EpiBf {
    static constexpr bool PERM = true, AFTER_DRAIN = false;
    bf16_t* O; int ldc;
    __device__ __forceinline__ void operator()(const f32x4 (&acc)[2][2][4][2], const Unit& u, int wr, int wc, int fr, int fq) const {
        const int row0 = u.pm * BM + wr * 64 + fr, col0 = u.pn * BM + wc * 32 + 8 * fq;
#pragma unroll
        for (int ai = 0; ai < 2; ++ai)
#pragma unroll
            for (int m = 0; m < 4; ++m) { bf16_t* rowp = O + (size_t)(row0 + ai * HALF + m * 16) * ldc + col0;
#pragma unroll
                for (int bj = 0; bj < 2; ++bj) { const f32x4 v0 = acc[ai][bj][m][0], v1 = acc[ai][bj][m][1];
                    u32x4 w; w.x = cvt_pk_bf16(v0[0], v0[1]); w.y = cvt_pk_bf16(v0[2], v0[3]); w.z = cvt_pk_bf16(v1[0], v1[1]); w.w = cvt_pk_bf16(v1[2], v1[3]);
                    *(u32x4*)(rowp + bj * HALF) = w; } }
    }
};
template <class Epi, class Sched, bool ALIGN_EPI = false, bool SP2 = false>
__device__ __forceinline__ void gemm_phase(PG8_LAS unsigned char* lds, const Gemm g, const Sched& S, const Epi& E, const int wave_id_) {
    const int tid_ = wave_id_ * 64 + lane_id_opaque();
    const int tid = tid_, wid = __builtin_amdgcn_readfirstlane(tid >> 6), lane = tid & 63, wr = wid >> 2, wc = wid & 3, fr = lane & 15, fq = lane >> 4;
    const int K = g.K, nt = K / BK;
    unsigned voffA[2], voffB[2];
#pragma unroll
    for (int i = 0; i < 2; ++i) { int R, C; stage_rc(tid * 16 + i * 8192, R, C); const int Rb = Epi::PERM ? ((R & ~31) + perm32(R & 31)) : R;
        voffA[i] = (unsigned)(R * K + C) * 2u; voffB[i] = (unsigned)(Rb * K + C) * 2u; }
    const size_t kstep = (size_t)(BK * 2);
    const size_t hstep = (size_t)HALF * K * 2;
    const size_t tstep = 2 * hstep;
    const unsigned ldsw = (unsigned)wid * 1024u;
    const int aoff = lds_byte(wr * 64 + fr, fq * 8), boff = lds_byte(wc * 32 + fr, fq * 8);
#define PG8_SA(b, h) (((b) * 2 + (h)) * HTB)
#define PG8_SB(b, h) ((4 + (b) * 2 + (h)) * HTB)
#define PG8_STAGE(bufoff, gbase, voff) do { _Pragma("unroll") for (int _i = 0; _i < 2; ++_i) \
        __builtin_amdgcn_global_load_lds((const unsigned*)((const char*)(gbase) + (voff)[_i]), (PG8_LAS unsigned*)(lds + (bufoff) + ldsw + _i * 8192), 16, 0, 0); } while (0)
#define PG8_LDA(dst, b, h) do { _Pragma("unroll") for (int m = 0; m < 4; ++m) _Pragma("unroll") for (int k = 0; k < 2; ++k) dst[m][k] = *(const PG8_LAS bf16x8*)(lds + PG8_SA(b, h) + aoff + m * 2048 + k * 1024); } while (0)
#define PG8_LDB(dst, b, h) do { _Pragma("unroll") for (int n = 0; n < 2; ++n) _Pragma("unroll") for (int k = 0; k < 2; ++k) dst[n][k] = *(const PG8_LAS bf16x8*)(lds + PG8_SB(b, h) + boff + n * 2048 + k * 1024); } while (0)
#define PG8_MMA(ai, bj, At, Bt) do { __builtin_amdgcn_s_setprio(1); _Pragma("unroll") for (int m = 0; m < 4; ++m) _Pragma("unroll") for (int n = 0; n < 2; ++n) _Pragma("unroll") for (int k = 0; k < 2; ++k) \
        acc[ai][bj][m][n] = __builtin_amdgcn_mfma_f32_16x16x32_bf16(Bt[n][k], At[m][k], acc[ai][bj][m][n], 0, 0, 0); __builtin_amdgcn_s_setprio(0); } while (0)
#define PG8_WAIT_V(n) asm volatile("s_waitcnt vmcnt(" #n ")" ::: "memory")
#define PG8_WAIT_L(n) asm volatile("s_waitcnt lgkmcnt(" #n ")" ::: "memory")
#define PG8_BAR __builtin_amdgcn_s_barrier()
#define PG8_SCHED __builtin_amdgcn_sched_barrier(0)
    Unit cur, nxt; int ui = 0;
    if (!S.next(0, cur)) return;
    f32x4 acc[2][2][4][2];
#pragma unroll
    for (int a = 0; a < 2; ++a)
#pragma unroll
        for (int b = 0; b < 2; ++b)
#pragma unroll
            for (int m = 0; m < 4; ++m)
#pragma unroll
                for (int n = 0; n < 2; ++n) acc[a][b][m][n] = (f32x4){0.f, 0.f, 0.f, 0.f};
    bf16x8 At[4][2], B0[2][2], B1[2][2];
    const char* cA = (const char*)g.A + (size_t)cur.pm * tstep; const char* cB = (const char*)g.Bt + (size_t)cur.pn * tstep;
    S.a_ready(cur);
    if constexpr (SP2) {
        PG8_STAGE(PG8_SB(0, 0), cB, voffB); PG8_STAGE(PG8_SB(0, 1), cB + hstep, voffB); PG8_STAGE(PG8_SA(0, 0), cA, voffA); PG8_STAGE(PG8_SA(0, 1), cA + hstep, voffA);
        if (wr == 1) PG8_BAR;
        PG8_WAIT_V(2); PG8_BAR;
        PG8_STAGE(PG8_SB(1, 0), cB + kstep, voffB); PG8_STAGE(PG8_SA(1, 0), cA + kstep, voffA); PG8_STAGE(PG8_SB(1, 1), cB + hstep + kstep, voffB);
        PG8_WAIT_V(6); PG8_BAR;
    } else {
        PG8_STAGE(PG8_SB(0, 0), cB, voffB); PG8_STAGE(PG8_SA(0, 0), cA, voffA); PG8_STAGE(PG8_SB(0, 1), cB + hstep, voffB); PG8_STAGE(PG8_SA(0, 1), cA + hstep, voffA);
        if (wr == 1) PG8_BAR;
        PG8_WAIT_V(4); PG8_BAR;
        PG8_STAGE(PG8_SB(1, 0), cB + kstep, voffB); PG8_STAGE(PG8_SA(1, 0), cA + kstep, voffA); PG8_STAGE(PG8_SB(1, 1), cB + hstep + kstep, voffB);
        PG8_WAIT_V(6); PG8_BAR;
    }
    for (;;) {
        const bool has_next = S.next(ui + 1, nxt);
        const char* nA = has_next ? (const char*)g.A + (size_t)nxt.pm * tstep : cA; const char* nB = has_next ? (const char*)g.Bt + (size_t)nxt.pn * tstep : cB;
        for (int t = 0; t < nt; t += 2) {
            const bool last = (t == nt - 2);
            const char* a1 = cA + (size_t)(t + 1) * kstep;
            const char* a2 = last ? nA : cA + (size_t)(t + 2) * kstep; const char* b2 = last ? nB : cB + (size_t)(t + 2) * kstep;
            const char* a3 = a2 + kstep; const char* b3 = b2 + kstep;
            if (last && has_next) S.a_ready(nxt);
            if constexpr (SP2) {
            PG8_LDB(B0, 0, 0); PG8_LDB(B1, 0, 1); PG8_SCHED; PG8_LDA(At, 0, 0); PG8_STAGE(PG8_SA(1, 1), a1 + hstep, voffA);
            PG8_WAIT_V(8); PG8_WAIT_L(0); PG8_BAR; PG8_MMA(0, 0, At, B0); PG8_MMA(0, 1, At, B1); PG8_BAR; PG8_SCHED;
            PG8_LDA(At, 0, 1); PG8_STAGE(PG8_SB(0, 0), b2, voffB); PG8_STAGE(PG8_SB(0, 1), b2 + hstep, voffB); PG8_STAGE(PG8_SA(0, 0), a2, voffA);
            PG8_WAIT_V(8); PG8_WAIT_L(0); PG8_BAR; PG8_MMA(1, 0, At, B0); PG8_MMA(1, 1, At, B1); PG8_BAR; PG8_SCHED;
            PG8_LDB(B0, 1, 0); PG8_LDB(B1, 1, 1); PG8_SCHED; PG8_LDA(At, 1, 0); PG8_STAGE(PG8_SA(0, 1), a2 + hstep, voffA);
            PG8_WAIT_V(8); PG8_WAIT_L(0); PG8_BAR; PG8_MMA(0, 0, At, B0); PG8_MMA(0, 1, At, B1); PG8_BAR; PG8_SCHED;
            PG8_LDA(At, 1, 1); PG8_STAGE(PG8_SB(1, 0), b3, voffB); PG8_STAGE(PG8_SB(1, 1), b3 + hstep, voffB); PG8_STAGE(PG8_SA(1, 0), a3, voffA);
            PG8_WAIT_V(8); PG8_WAIT_L(0); PG8_BAR; PG8_MMA(1, 0, At, B0); PG8_MMA(1, 1, At, B1); PG8_BAR; PG8_SCHED;
            } else {
            PG8_LDB(B0, 0, 0); PG8_SCHED; PG8_LDA(At, 0, 0); PG8_STAGE(PG8_SA(1, 1), a1 + hstep, voffA);
            PG8_WAIT_L(8); PG8_BAR; PG8_WAIT_L(0); PG8_MMA(0, 0, At, B0); PG8_BAR; PG8_SCHED;
            PG8_LDB(B1, 0, 1); PG8_STAGE(PG8_SB(0, 0), b2, voffB);
            PG8_BAR; PG8_WAIT_L(0); PG8_MMA(0, 1, At, B1); PG8_BAR;
            PG8_LDA(At, 0, 1); PG8_STAGE(PG8_SA(0, 0), a2, voffA);
            PG8_BAR; PG8_WAIT_L(0); PG8_MMA(1, 0, At, B0); PG8_BAR; PG8_SCHED;
            PG8_STAGE(PG8_SB(0, 1), b2 + hstep, voffB);
            PG8_WAIT_V(6); PG8_BAR; PG8_MMA(1, 1, At, B1); PG8_BAR;
            PG8_LDB(B0, 1, 0); PG8_SCHED; PG8_LDA(At, 1, 0); PG8_STAGE(PG8_SA(0, 1), a2 + hstep, voffA);
            PG8_WAIT_L(8); PG8_BAR; PG8_WAIT_L(0); PG8_MMA(0, 0, At, B0); PG8_BAR; PG8_SCHED;
            PG8_LDB(B1, 1, 1); PG8_STAGE(PG8_SB(1, 0), b3, voffB);
            PG8_BAR; PG8_WAIT_L(0); PG8_MMA(0, 1, At, B1); PG8_BAR;
            PG8_LDA(At, 1, 1); PG8_STAGE(PG8_SA(1, 0), a3, voffA);
            PG8_BAR; PG8_WAIT_L(0); PG8_MMA(1, 0, At, B0); PG8_BAR; PG8_SCHED;
            PG8_STAGE(PG8_SB(1, 1), b3 + hstep, voffB);
            PG8_WAIT_V(6); PG8_BAR; PG8_MMA(1, 1, At, B1); PG8_BAR;
            }
        }
        if constexpr (ALIGN_EPI) { if (wr == 0) PG8_BAR; }
        if constexpr (!Epi::AFTER_DRAIN) { E(acc, cur, wr, wc, fr, fq); S.done(cur); }
        if (!has_next) break;
#pragma unroll
        for (int a = 0; a < 2; ++a)
#pragma unroll
            for (int b = 0; b < 2; ++b)
#pragma unroll
                for (int m = 0; m < 4; ++m)
#pragma unroll
                    for (int n = 0; n < 2; ++n) acc[a][b][m][n] = (f32x4){0.f, 0.f, 0.f, 0.f};
        cur = nxt; cA = nA; cB = nB; ++ui;
        if constexpr (ALIGN_EPI) { if (wr == 1) PG8_BAR; }
    }
    PG8_WAIT_V(0);
    if constexpr (!ALIGN_EPI) { if (wr == 0) PG8_BAR; }
    PG8_BAR;
    if constexpr (Epi::AFTER_DRAIN) { E.fused(acc, cur, wr, wc, fr, fq, lds, wid, lane); S.done(cur); }
#undef PG8_SA
#undef PG8_SB
#undef PG8_STAGE
#undef PG8_LDA
#undef PG8_LDB
#undef PG8_MMA
#undef PG8_WAIT_V
#undef PG8_WAIT_L
#undef PG8_BAR
#undef PG8_SCHED
}
}
#define GAS __attribute__((address_space(1)))
#define LAS __attribute__((address_space(3)))
typedef unsigned short bf16;
typedef unsigned v4u __attribute__((ext_vector_type(4)));
typedef unsigned v2u __attribute__((ext_vector_type(2)));
typedef float f32x4 __attribute__((ext_vector_type(4)));
typedef float f32x2 __attribute__((ext_vector_type(2)));
typedef float f32x16 __attribute__((ext_vector_type(16)));
typedef short bf16x8 __attribute__((ext_vector_type(8)));
typedef short s16x4 __attribute__((ext_vector_type(4)));
typedef GAS unsigned gu32;
#define LDS_WAIT() asm volatile("s_waitcnt lgkmcnt(0)" ::: "memory")
#define VM_WAIT() asm volatile("s_waitcnt vmcnt(0)" ::: "memory")
__device__ __forceinline__ unsigned f2bf(float f) { unsigned u = __builtin_bit_cast(unsigned, f); return (u + 0x7fffu + ((u >> 16) & 1u)) >> 16; }
__device__ __forceinline__ unsigned pk2(float lo, float hi) { return f2bf(lo) | (f2bf(hi) << 16); }
__device__ __forceinline__ float bflo(unsigned w) { return __builtin_bit_cast(float, w << 16); }
__device__ __forceinline__ float bfhi(unsigned w) { return __builtin_bit_cast(float, w & 0xffff0000u); }
#define XB_TMO      128
#define XB_XCNT(j)  (256  + 64 * (j))
#define XB_XSUB(j)  (1280 + 64 * (j))
#define XB_XGEN(j)  (2304 + 64 * (j))
#define XB_TOP      3328
#define XB_TOPGEN   3392
#define XCD_BAR_WORDS 3456
#define XB_SPIN_CAP (1u << 18)

__device__ __forceinline__ unsigned xb_ld(unsigned* p)              { return __hip_atomic_load(p, __ATOMIC_RELAXED, __HIP_MEMORY_SCOPE_AGENT); }
__device__ __forceinline__ unsigned xb_add(unsigned* p, unsigned v) { return __hip_atomic_fetch_add(p, v, __ATOMIC_RELAXED, __HIP_MEMORY_SCOPE_AGENT); }
__device__ __forceinline__ unsigned xb_xcc_id() { return (unsigned)__builtin_amdgcn_s_getreg((3 << 11) | 20) & 0xFu; }
#define XB_SPIN(cond, bar) do { unsigned _sp = 0; while (cond) { __builtin_amdgcn_s_sleep(1); \
    if ((++_sp & 255u) == 0u) { if (xb_ld(&(bar)[XB_TMO])) break; if (_sp > XB_SPIN_CAP) { atomicAdd(&(bar)[XB_TMO], 1u); break; } } } } while (0)

struct XcdBarrier {
    unsigned* bar; unsigned x;
    volatile LAS unsigned* st;
};

__device__ __forceinline__ XcdBarrier xcd_barrier_post(unsigned* bar, volatile LAS unsigned* st, const bool thread0) {
    XcdBarrier b; b.bar = bar; b.x = xb_xcc_id(); b.st = st;
    if (thread0) (void)xb_add(&bar[XB_XCNT(b.x)], 1u);
    return b;
}
__device__ __forceinline__ void xcd_barrier_complete(unsigned* bar, unsigned x, unsigned& nloc, unsigned& nx) {
    const unsigned G = gridDim.x * gridDim.y * gridDim.z;
    unsigned sum, cnt, mine, sp = 0u;
    for (;;) {
        sum = 0u; cnt = 0u; mine = 0u;
#pragma unroll
        for (unsigned j = 0; j < 16; ++j) { const unsigned c = xb_ld(&bar[XB_XCNT(j)]); sum += c; cnt += (c > 0u) ? 1u : 0u; mine = (j == x) ? c : mine; }
        if (sum == G) break;
        __builtin_amdgcn_s_sleep(1);
        if ((++sp & 255u) == 0u) { if (xb_ld(&bar[XB_TMO])) break; if (sp > XB_SPIN_CAP) { atomicAdd(&bar[XB_TMO], 1u); break; } }
    }
    nloc = mine > 0u ? mine : 1u; nx = cnt > 0u ? cnt : 1u;
}

__device__ __forceinline__ void xcd_barrier(const XcdBarrier& b, const bool thread0) {
    asm volatile("s_waitcnt vmcnt(0)" ::: "memory");
    __syncthreads();
    if (thread0) {
        unsigned* bar = b.bar;
        __builtin_amdgcn_s_waitcnt(0);
        unsigned nloc = b.st[0], nx = b.st[1];
        if (nloc == 0u) { xcd_barrier_complete(bar, b.x, nloc, nx); b.st[0] = nloc; b.st[1] = nx; }
        const unsigned old = xb_add(&bar[XB_XSUB(b.x)], 1u);
        const unsigned gen = old / nloc;
        if (old + 1u == (gen + 1u) * nloc) {
            __builtin_amdgcn_fence(__ATOMIC_RELEASE, "agent");
            asm volatile("s_waitcnt vmcnt(0)" ::: "memory");
            const unsigned og = xb_add(&bar[XB_TOP], 1u);
            const unsigned tg = og / nx;
            if (og + 1u == (tg + 1u) * nx) xb_add(&bar[XB_TOPGEN], 1u);
            else XB_SPIN(xb_ld(&bar[XB_TOPGEN]) == tg, bar);
            __builtin_amdgcn_fence(__ATOMIC_ACQUIRE, "agent");
            xb_add(&bar[XB_XGEN(b.x)], 1u);
            asm volatile("s_waitcnt vmcnt(0)" ::: "memory");
        } else {
            XB_SPIN(xb_ld(&bar[XB_XGEN(b.x)]) == gen, bar);
            __builtin_amdgcn_fence(__ATOMIC_ACQUIRE, "agent");
            asm volatile("s_waitcnt vmcnt(0)" ::: "memory");
        }
    }
    __syncthreads();
}
constexpr size_t MiB = 1u << 20;
constexpr size_t WS_CTL = 0, CTL_ZERO_BYTES = 1 * MiB;
constexpr size_t WS_WIN = 2 * MiB;
constexpr size_t WS_WOUT = WS_WIN + 16 * MiB;
constexpr size_t WS_WUP = WS_WOUT + 8 * MiB;
constexpr size_t WS_WDN = WS_WUP + 44 * MiB;
constexpr size_t WS_WDQ0 = WS_WDN + 22 * MiB;
constexpr size_t WS_WDQ1 = WS_WDQ0 + 2 * MiB;
constexpr size_t WS_WUQ = WS_WDQ1 + 1 * MiB;
constexpr size_t WS_WKV = WS_WUQ + 3 * MiB;
constexpr size_t WS_WUKN = WS_WKV + 1 * MiB;
constexpr size_t WS_WO = WS_WUKN + 1 * MiB;
constexpr size_t WS_ROPE = WS_WO + 4 * MiB;
constexpr size_t WS_X = WS_ROPE + 1 * MiB;
constexpr size_t WS_XB = WS_X + 64 * MiB;
constexpr size_t WS_RSTD = WS_XB + 32 * MiB;
constexpr size_t WS_U = WS_RSTD + 1 * MiB;
constexpr size_t WS_V = WS_U + 64 * MiB;
constexpr size_t WS_VSS = WS_V + 64 * MiB;
constexpr size_t WS_G2 = WS_VSS + 2 * MiB;
constexpr size_t WS_MO = WS_G2 + 64 * MiB;
constexpr size_t WS_MSS = WS_MO + 64 * MiB;
constexpr size_t WS_AB = WS_MSS + 1 * MiB;
constexpr size_t WS_GU = WS_AB + 176 * MiB;
constexpr size_t WS_CQ = WS_GU + 88 * MiB;
constexpr size_t WS_CQSS = WS_CQ + 16 * MiB;
constexpr size_t WS_KVR = WS_CQSS + 1 * MiB;
constexpr size_t WS_Q = WS_KVR + 20 * MiB;
constexpr size_t WS_CKVB = WS_Q + 48 * MiB;
constexpr size_t WS_KRB = WS_CKVB + 8 * MiB;
constexpr size_t WS_KN = WS_KRB + 2 * MiB;
constexpr size_t WS_VT = WS_KN + 32 * MiB;
constexpr size_t WS_OB = WS_VT + 32 * MiB;
constexpr size_t WS_FAST_END = WS_OB + 32 * MiB;
constexpr size_t WS_NAIVE = 1024 * MiB;
static_assert(WS_FAST_END <= WS_NAIVE, "ws map");
constexpr int CW_TMO = 0, CW_CODE = 1, CW_BAR = 4096;
constexpr int RING_OFF = 0, RING_BYTES = 131072;
constexpr int XL_OFF = 131072;
constexpr int LDSCTL_OFF = 139264, MISC_OFF = LDSCTL_OFF + 320;
constexpr int LDS_BYTES = 147456;
constexpr int NWAVES = 8;
constexpr float LOG2E = 1.4426950408889634f;

struct Frame { LAS unsigned char* lds; volatile LAS unsigned* MISC; gu32* ctl; int tid, lane, wave, vcu, G; };
#define CAS __attribute__((address_space(4)))
struct Args {
    const GAS float *x_prompt, *x_sample, *cache_ckv, *cache_kr, *state_conv; const GAS int* page_table;
    const GAS float *pre_mix_g, *post_mix_g, *pre_ffn_g, *post_ffn_g, *w_in_a, *sgu_g, *w_s, *b_s, *w_out_a, *kv_in_g, *w_dkv, *kv_g, *w_uk, *w_uv, *w_dq, *q_g, *w_uq, *w_o, *w_up, *conv_w, *conv_b, *w_down;
    GAS float* out; GAS unsigned char* ws; int ph_lo, ph_hi;
};
typedef const CAS Args* ArgsP;
__device__ __forceinline__ float wave_sum(float v) {
#pragma unroll
    for (int o = 1; o < 64; o <<= 1) v += __shfl_xor(v, o);
    return v;
}
__device__ __forceinline__ void p0_transpose_item(const float* W, int K, int N, bf16* WT, int row_off, const float* kscale, float cscale, int mode, LAS float* scr, int item, int lane) {
    const int nblk = N / 64, kb = item / nblk, nb = item % nblk, k0 = 64 * kb, n0 = 64 * nb;
    float v[64];
#pragma unroll
    for (int i = 0; i < 64; ++i) v[i] = W[(size_t)(k0 + i) * N + n0 + lane];
    if (kscale) {
#pragma unroll
        for (int i = 0; i < 64; i += 4) { const f32x4 sc = *(const GAS f32x4*)(kscale + k0 + i); v[i] *= sc.x; v[i + 1] *= sc.y; v[i + 2] *= sc.z; v[i + 3] *= sc.w; }
    }
#pragma unroll
    for (int i = 0; i < 64; ++i) scr[i * 65 + lane] = v[i] * cscale;
    LDS_WAIT(); asm volatile("" ::: "memory");
    const int c = lane & 7;
#pragma unroll
    for (int j = 0; j < 8; ++j) { const int n = (lane >> 3) + 8 * j; const LAS float* s = scr + (8 * c) * 65 + n;
        v4u o; o.x = pk2(s[0 * 65], s[1 * 65]); o.y = pk2(s[2 * 65], s[3 * 65]); o.z = pk2(s[4 * 65], s[5 * 65]); o.w = pk2(s[6 * 65], s[7 * 65]);
        int dr = n0 + n;
        if (mode == 2) { const int h = dr / 192, cin = dr % 192; if (cin >= 128) { const int i = cin - 128; dr = h * 192 + 128 + 2 * (i & 31) + (i >> 5); } }
        if (mode == 1) { const int half = dr / 2816, jj = dr % 2816; dr = (jj >> 7) * 256 + half * 128 + (jj & 127); }
        *(GAS v4u*)(WT + (size_t)(row_off + dr) * K + k0 + 8 * c) = o; }
    LDS_WAIT(); asm volatile("" ::: "memory");
}
__device__ __forceinline__ void p0_prologue(Frame& F, ArgsP Ap) {
    GAS unsigned char* ws = Ap->ws;
    LAS float* scr = (LAS float*)(F.lds + RING_OFF + F.wave * 16640);
    const int gw = F.vcu * NWAVES + F.wave, NGW = F.G * NWAVES;
    constexpr int I_IN = 16 * 64, I_OUT = 32 * 16, I_UP = 16 * 88, I_DN = 44 * 16, I_DQ = 16 * 8, I_DKV = 16 * 5, I_UQ = 8 * 24, I_KV = 4 * 16, I_O = 16 * 16;
    constexpr int NITEMS = 2 * I_IN + 2 * I_OUT + 4 * I_UP + 4 * I_DN + 2 * I_DQ + I_DKV + 2 * I_UQ + 2 * I_KV + 2 * I_O;
    for (int it = gw; it < NITEMS; it += NGW) {
        int r = it;
        if (r < 2 * I_IN) { const int l = r / I_IN; p0_transpose_item(((const float*)Ap->w_in_a) + (size_t)l * 1024 * 4096, 1024, 4096, (bf16*)(ws + WS_WIN) + (size_t)l * 4096 * 1024, 0, ((const float*)Ap->pre_mix_g) + l * 1024, 1.0f, 0, scr, r % I_IN, F.lane); continue; } r -= 2 * I_IN;
        if (r < 2 * I_OUT) { const int l = r / I_OUT; p0_transpose_item(((const float*)Ap->w_out_a) + (size_t)l * 2048 * 1024, 2048, 1024, (bf16*)(ws + WS_WOUT) + (size_t)l * 1024 * 2048, 0, nullptr, 1.0f, 0, scr, r % I_OUT, F.lane); continue; } r -= 2 * I_OUT;
        if (r < 4 * I_UP) { const int l = r / I_UP; p0_transpose_item(((const float*)Ap->w_up) + (size_t)l * 1024 * 5632, 1024, 5632, (bf16*)(ws + WS_WUP) + (size_t)l * 5632 * 1024, 0, ((const float*)Ap->pre_ffn_g) + l * 1024, 1.0f, 1, scr, r % I_UP, F.lane); continue; } r -= 4 * I_UP;
        if (r < 4 * I_DN) { const int l = r / I_DN; p0_transpose_item(((const float*)Ap->w_down) + (size_t)l * 2816 * 1024, 2816, 1024, (bf16*)(ws + WS_WDN) + (size_t)l * 1024 * 2816, 0, nullptr, 1.0f, 0, scr, r % I_DN, F.lane); continue; } r -= 4 * I_DN;
        if (r < 2 * I_DQ) { const int j = r / I_DQ; p0_transpose_item(((const float*)Ap->w_dq) + (size_t)j * 1024 * 512, 1024, 512, (bf16*)(ws + (j ? WS_WDQ1 : WS_WDQ0)), 0, ((const float*)Ap->pre_mix_g) + (2 + j) * 1024, 1.0f, 0, scr, r % I_DQ, F.lane); continue; } r -= 2 * I_DQ;
        if (r < I_DKV) { p0_transpose_item(((const float*)Ap->w_dkv), 1024, 320, (bf16*)(ws + WS_WDQ0), 512, ((const float*)Ap->kv_in_g), 1.0f, 0, scr, r, F.lane); continue; } r -= I_DKV;
        if (r < 2 * I_UQ) { const int j = r / I_UQ; p0_transpose_item(((const float*)Ap->w_uq) + (size_t)j * 512 * 1536, 512, 1536, (bf16*)(ws + WS_WUQ) + (size_t)j * 1536 * 512, 0, ((const float*)Ap->q_g) + j * 512, 0.07216878364870322f * LOG2E, 2, scr, r % I_UQ, F.lane); continue; } r -= 2 * I_UQ;
        if (r < 2 * I_KV) { const int j = r / I_KV; p0_transpose_item(j ? ((const float*)Ap->w_uv) : ((const float*)Ap->w_uk), 256, 1024, (bf16*)(ws + WS_WKV), j * 1024, nullptr, 1.0f, 0, scr, r % I_KV, F.lane); continue; } r -= 2 * I_KV;
        { const int j = r / I_O; p0_transpose_item(((const float*)Ap->w_o) + (size_t)j * 1024 * 1024, 1024, 1024, (bf16*)(ws + WS_WO) + (size_t)j * 1024 * 1024, 0, nullptr, 1.0f, 0, scr, r % I_O, F.lane); }
    }
    { const int gt = F.vcu * 512 + F.tid, NT = F.G * 512; GAS v4u* z = (GAS v4u*)(ws + WS_WDQ0 + (size_t)832 * 1024 * 2);
      for (int i = gt; i < 192 * 1024 * 2 / 16; i += NT) z[i] = (v4u){0u, 0u, 0u, 0u}; }
    { const int gt = F.vcu * 512 + F.tid, NT = F.G * 512; GAS unsigned* o = (GAS unsigned*)(ws + WS_WUKN);
      for (int i = gt; i < 256 * 1024 / 2; i += NT) o[i] = pk2(((const float*)Ap->w_uk)[2 * i], ((const float*)Ap->w_uk)[2 * i + 1]); }
    { const int gt = F.vcu * 512 + F.tid, NT = F.G * 512; GAS float* tab = (GAS float*)(ws + WS_ROPE);
      for (int i = gt; i < 2049 * 32; i += NT) { const int p = i >> 5, k = i & 31; const int pos = p == 2048 ? 8192 : p;
          const float inv = 1.0f / powf(10000.0f, (float)k / 32.0f); const float ang = (float)pos * inv; float sn, cs; sincosf(ang, &sn, &cs); tab[2 * i] = cs; tab[2 * i + 1] = sn; } }
    { GAS float* X = (GAS float*)(ws + WS_X); GAS float* RS = (GAS float*)(ws + WS_RSTD);
      for (int m = gw; m < MP; m += NGW) {
          const GAS f32x4* xr = (const GAS f32x4*)(((const float*)Ap->x_prompt) + (size_t)m * 1024) + F.lane; GAS f32x4* xo = (GAS f32x4*)(X + (size_t)m * 1024) + F.lane;
          GAS v2u* xb = (GAS v2u*)(ws + WS_XB + (size_t)m * 2048) + F.lane; float s = 0.f;
#pragma unroll
          for (int j = 0; j < 4; ++j) { const f32x4 v = xr[64 * j]; xo[64 * j] = v; s += (v.x * v.x + v.y * v.y) + (v.z * v.z + v.w * v.w); xb[64 * j] = (v2u){pk2(v.x, v.y), pk2(v.z, v.w)}; }
          s = wave_sum(s); if (F.lane == 0) RS[m] = rsqrtf(s * (1.0f / 1024.0f) + EPS); } }
}
__device__ __forceinline__ void thin_post(Frame& F, const float* MO, const float* SS, const float* gain, float* X, bf16* XB, float* RSTD, float* Y) {
    const int gw = F.vcu * NWAVES + F.wave, NGW = F.G * NWAVES;
    for (int m = gw; m < MP; m += NGW) {
        float ss = SS[(size_t)m * 16 + (F.lane & 15)]; ss += __shfl_xor(ss, 1); ss += __shfl_xor(ss, 2); ss += __shfl_xor(ss, 4); ss += __shfl_xor(ss, 8);
        const float rm = rsqrtf(ss * (1.0f / 1024.0f) + EPS);
        const GAS f32x4* mr = (const GAS f32x4*)(MO + (size_t)m * 1024) + F.lane; const GAS f32x4* gr = (const GAS f32x4*)gain + F.lane; GAS f32x4* xr = (GAS f32x4*)(X + (size_t)m * 1024) + F.lane;
        GAS v2u* xb = (GAS v2u*)(XB + (size_t)m * 1024) + F.lane; float s = 0.f;
#pragma unroll
        for (int j = 0; j < 4; ++j) { const f32x4 mv = mr[64 * j], g = gr[64 * j]; f32x4 x = xr[64 * j]; x = x + mv * rm * g; xr[64 * j] = x; if (Y) ((GAS f32x4*)(Y + (size_t)m * 1024) + F.lane)[64 * j] = x;
            s += (x.x * x.x + x.y * x.y) + (x.z * x.z + x.w * x.w); xb[64 * j] = (v2u){pk2(x.x, x.y), pk2(x.z, x.w)}; }
        s = wave_sum(s); if (F.lane == 0) RSTD[m] = rsqrtf(s * (1.0f / 1024.0f) + EPS);
    }
}
typedef short v4i16_t __attribute__((__vector_size__(4 * sizeof(short))));
__device__ __forceinline__ s16x4 tr_read(LAS unsigned char* p) { return __builtin_bit_cast(s16x4, __builtin_amdgcn_ds_read_tr16_b64_v4i16((LAS v4i16_t*)p)); }
__device__ __forceinline__ void sgu_phase(Frame& F, const bf16* U, const bf16* V, const float* VSS, const float* w_s, const float* b_s, const float* sgu_g, bf16* G2) {
    constexpr int WSM_OFF = 0, WSM_LD = 272, VT_OFF = 34816, VT_LD = 528, RS_OFF = 102400;
    LAS unsigned char* lds = F.lds; LAS float* RS = (LAS float*)(lds + RS_OFF);
    const int lane = F.lane, w = F.wave, q = lane >> 4, i16 = lane & 15;
    for (int unit = F.vcu; unit < 1024; unit += F.G) {
        const int chunk = unit >> 3, g = unit & 7, row0 = chunk * 128;
        __syncthreads();
        if (F.tid < 128) { const GAS f32x4* p = (const GAS f32x4*)(VSS + (size_t)(row0 + F.tid) * 32); float s = 0.f;
#pragma unroll
            for (int k = 0; k < 8; ++k) { const f32x4 v = p[k]; s += (v.x + v.y) + (v.z + v.w); }
            RS[F.tid] = rsqrtf(s * (1.0f / 2048.0f) + EPS); }
        __syncthreads();
#pragma unroll
        for (int k = 0; k < 8; ++k) { const int idx = F.tid + 512 * k, t = idx >> 5, s4 = (idx & 31) * 4; const f32x4 wv = *(const GAS f32x4*)(w_s + ((size_t)g * 128 + t) * 128 + s4);
            const float a0 = s4 + 0 <= t ? wv.x * RS[s4 + 0] : 0.f, a1 = s4 + 1 <= t ? wv.y * RS[s4 + 1] : 0.f, a2 = s4 + 2 <= t ? wv.z * RS[s4 + 2] : 0.f, a3 = s4 + 3 <= t ? wv.w * RS[s4 + 3] : 0.f;
            *(LAS v2u*)(lds + WSM_OFF + t * WSM_LD + s4 * 2) = (v2u){pk2(a0, a1), pk2(a2, a3)}; }
#pragma unroll
        for (int k = 0; k < 8; ++k) { const int idx = F.tid + 512 * k, s = idx >> 5, ch = idx & 31; const v4u vv = *(const GAS v4u*)(V + (size_t)(row0 + s) * 2048 + g * 256 + ch * 8);
            *(LAS v4u*)(lds + VT_OFF + s * VT_LD + ch * 16) = vv; }
        __syncthreads();
        f32x4 acc[8][2];
#pragma unroll
        for (int tb = 0; tb < 8; ++tb) { acc[tb][0] = (f32x4){0.f, 0.f, 0.f, 0.f}; acc[tb][1] = (f32x4){0.f, 0.f, 0.f, 0.f}; }
#pragma unroll
        for (int ks = 0; ks < 4; ++ks) {
            bf16x8 xf[2];
#pragma unroll
            for (int dbi = 0; dbi < 2; ++dbi) { LAS unsigned char* p = lds + VT_OFF + (32 * ks + 8 * q + (i16 >> 2)) * VT_LD + (16 * (2 * w + dbi) + 4 * (i16 & 3)) * 2;
                const s16x4 lo = tr_read(p), hi = tr_read(p + 4 * VT_LD); xf[dbi] = (bf16x8){lo[0], lo[1], lo[2], lo[3], hi[0], hi[1], hi[2], hi[3]}; }
#pragma unroll
            for (int tb = 2 * ks; tb < 8; ++tb) { const bf16x8 yf = *(const LAS bf16x8*)(lds + WSM_OFF + (16 * tb + i16) * WSM_LD + (32 * ks + 8 * q) * 2);
                acc[tb][0] = __builtin_amdgcn_mfma_f32_16x16x32_bf16(xf[0], yf, acc[tb][0], 0, 0, 0);
                acc[tb][1] = __builtin_amdgcn_mfma_f32_16x16x32_bf16(xf[1], yf, acc[tb][1], 0, 0, 0); }
        }
#pragma unroll
        for (int dbi = 0; dbi < 2; ++dbi) { const int d = g * 256 + 16 * (2 * w + dbi) + 4 * q; const f32x4 gg = *(const GAS f32x4*)(sgu_g + d);
#pragma unroll
            for (int tb = 0; tb < 8; ++tb) { const int t = 16 * tb + i16; const float bb = b_s[g * 128 + t]; const size_t off = (size_t)(row0 + t) * 2048 + d;
                const v2u uu = *(const GAS v2u*)(U + off); const f32x4 a = acc[tb][dbi];
                const float o0 = bflo(uu.x) * (a[0] * gg[0] + bb), o1 = bfhi(uu.x) * (a[1] * gg[1] + bb), o2 = bflo(uu.y) * (a[2] * gg[2] + bb), o3 = bfhi(uu.y) * (a[3] * gg[3] + bb);
                *(GAS v2u*)(G2 + off) = (v2u){pk2(o0, o1), pk2(o2, o3)}; } }
    }
    __syncthreads();
}
__device__ __forceinline__ float gelu_tanh_fast(float x) { const float u = 0.7978845608028654f * (x + 0.044715f * x * x * x); const float e = __builtin_amdgcn_exp2f(-2.0f * LOG2E * u); return x * __builtin_amdgcn_rcpf(1.0f + e); }
__device__ __forceinline__ void conv_patch_panel(Frame& F, int pm, const float* halo, const float* cw, const float* cb, bf16* GU) {
    if ((pm & 7) == 0) return;
    const float* hm2 = halo + ((size_t)(pm - 1) * 4 + 2) * 5632; const float* hm1 = hm2 + 5632; const float* h0 = halo + ((size_t)pm * 4) * 5632; const float* h1 = h0 + 5632;
    for (int j = F.tid; j < 2816; j += 512) {
        const float g_2 = hm2[j], g_1 = hm1[j], g0 = h0[j], g1 = h1[j], u_2 = hm2[j + 2816], u_1 = hm1[j + 2816], u0 = h0[j + 2816], u1 = h1[j + 2816];
        const float w0g = cw[j], w1g = cw[5632 + j], w2g = cw[2 * 5632 + j], bg = cb[j], w0u = cw[2816 + j], w1u = cw[5632 + 2816 + j], w2u = cw[2 * 5632 + 2816 + j], bu = cb[2816 + j];
        const float cg0 = bg + w0g * g_2 + w1g * g_1 + w2g * g0, cu0 = bu + w0u * u_2 + w1u * u_1 + w2u * u0;
        const float cg1 = bg + w0g * g_1 + w1g * g0 + w2g * g1, cu1 = bu + w0u * u_1 + w1u * u0 + w2u * u1;
        GU[(size_t)(pm * 256) * 2816 + j] = (bf16)f2bf(gelu_tanh_fast(cg0) * cu0);
        GU[(size_t)(pm * 256 + 1) * 2816 + j] = (bf16)f2bf(gelu_tanh_fast(cg1) * cu1);
    }
}
__device__ __forceinline__ void kvfinal_phase(Frame& F, const float* KVR, const float* kv_g, const float* rope, float* out_ckv, float* out_kr, bf16* CKVB, bf16* KRB) {
    const int gw = F.vcu * NWAVES + F.wave, NGW = F.G * NWAVES, lane = F.lane;
    for (int m = gw; m < MP; m += NGW) {
        const float* r = KVR + (size_t)m * 320;
        const f32x4 v = *(const GAS f32x4*)(r + 4 * lane); const f32x4 g = *(const GAS f32x4*)(kv_g + 4 * lane);
        float s = (v.x * v.x + v.y * v.y) + (v.z * v.z + v.w * v.w); s = wave_sum(s);
        const float rs = rsqrtf(s * (1.0f / 256.0f) + EPS);
        const f32x4 o = v * rs * g;
        *(GAS f32x4*)(out_ckv + (size_t)m * 256 + 4 * lane) = o;
        *(GAS v2u*)(CKVB + (size_t)m * 256 + 4 * lane) = (v2u){pk2(o.x, o.y), pk2(o.z, o.w)};
        if (lane < 32) { const float x1 = r[256 + lane], x2 = r[288 + lane]; const int pos = m & 2047; const f32x2 cs = *(const GAS f32x2*)(rope + ((size_t)pos * 32 + lane) * 2);
            const float o1 = x1 * cs.x - x2 * cs.y, o2 = x2 * cs.x + x1 * cs.y;
            out_kr[(size_t)m * 64 + lane] = o1; out_kr[(size_t)m * 64 + 32 + lane] = o2;
            *(GAS unsigned*)(KRB + (size_t)m * 64 + 2 * lane) = pk2(o1, o2); }
    }
}
constexpr int AT_KLD = 400, AT_VLD = 136, AT_VOFF = 25600, AT_STAGE = 43008;
__device__ __forceinline__ void attn_phase(Frame& F, const bf16* Q, const bf16* KN, const bf16* KRB, const bf16* VT, bf16* OB) {
    const int lane = F.lane, w = F.wave, tid = F.tid, r32 = lane & 31, hh = lane >> 5;
    LAS unsigned char* lds = F.lds;
    for (int p = F.vcu; p < 256; p += F.G) {
#pragma unroll 1
        for (int half = 0; half < 2; ++half) {
            const int bh = p >> 2, sidx = p & 3, qb = half ? 7 - sidx : sidx, b = bh >> 3, h = bh & 7;
            const int q0 = 256 * qb + 32 * w; const int nt = 4 * (qb + 1);
            const GAS unsigned char* q_t = (const GAS unsigned char*)(Q + ((size_t)b * 2048 + 256 * qb) * 1536 + h * 192);
            asm volatile("" : "+s"(q_t));
            const unsigned qoff = (unsigned)(32 * w + r32) * 3072u + (unsigned)hh * 16u;
            bf16x8 qf[12];
#pragma unroll
            for (int ks = 0; ks < 12; ++ks) qf[ks] = *(const GAS bf16x8*)(q_t + qoff + 32 * ks);
            v4u kreg[3], vreg[2];
            const GAS unsigned char* kn_t = (const GAS unsigned char*)(KN + ((size_t)b * 2048) * 1024 + h * 128);
            const GAS unsigned char* kr_t = (const GAS unsigned char*)(KRB + ((size_t)b * 2048) * 64);
            const GAS unsigned char* vt_t = (const GAS unsigned char*)(VT + ((size_t)h * 128) * MP + (size_t)b * 2048);
#define AT_LOAD(j) do { \
                const GAS unsigned char* kb_ = kn_t + (size_t)(j) * (64 * 2048); const GAS unsigned char* rb_ = kr_t + (size_t)(j) * (64 * 128); const GAS unsigned char* vb_ = vt_t + (size_t)(j) * 128; \
                asm volatile("" : "+s"(kb_), "+s"(rb_), "+s"(vb_));     \
                _Pragma("unroll") for (int i = 0; i < 2; ++i) { const unsigned c = tid + 512 * i; kreg[i] = *(const GAS v4u*)(kb_ + ((c >> 4) * 2048u + (c & 15u) * 16u)); } \
                kreg[2] = *(const GAS v4u*)(rb_ + (((unsigned)tid >> 3) * 128u + ((unsigned)tid & 7u) * 16u)); \
                _Pragma("unroll") for (int i = 0; i < 2; ++i) { const unsigned c = tid + 512 * i; vreg[i] = *(const GAS v4u*)(vb_ + ((c >> 3) * (unsigned)(MP * 2) + (c & 7u) * 16u)); } } while (0)
#define AT_STORE(st) do { \
                _Pragma("unroll") for (int i = 0; i < 2; ++i) { const unsigned c = tid + 512 * i; *(LAS v4u*)((st) + (c >> 4) * AT_KLD + (c & 15u) * 16u) = kreg[i]; } \
                *(LAS v4u*)((st) + ((unsigned)tid >> 3) * AT_KLD + 256 + ((unsigned)tid & 7u) * 16u) = kreg[2]; \
                _Pragma("unroll") for (int i = 0; i < 2; ++i) { const unsigned c = tid + 512 * i; LAS unsigned char* vp_ = (st) + AT_VOFF + (c >> 3) * AT_VLD + (c & 7u) * 16u; \
                    *(LAS v2u*)vp_ = (v2u){vreg[i].x, vreg[i].y}; *(LAS v2u*)(vp_ + 8) = (v2u){vreg[i].z, vreg[i].w}; } } while (0)
            AT_LOAD(0);
            float m_run = -1.0e30f, l_run = 0.f;
            f32x16 O[4];
#pragma unroll
            for (int db = 0; db < 4; ++db)
#pragma unroll
                for (int e = 0; e < 16; ++e) O[db][e] = 0.f;
            __syncthreads();
#pragma unroll 1
            for (int j = 0; j < nt; ++j) {
                LAS unsigned char* st = lds + (j & 1) * AT_STAGE;
                AT_STORE(st);
                __syncthreads();
                if (j + 1 < nt) AT_LOAD(j + 1);
                if (64 * j > q0 + 31) continue;
                f32x16 S[2];
#pragma unroll
                for (int kb = 0; kb < 2; ++kb) {
#pragma unroll
                    for (int e = 0; e < 16; ++e) S[kb][e] = 0.f;
#pragma unroll
                    for (int ks = 0; ks < 12; ++ks) { const bf16x8 kf = *(const LAS bf16x8*)(st + (32 * kb + r32) * AT_KLD + (16 * ks + 8 * hh) * 2);
                        S[kb] = __builtin_amdgcn_mfma_f32_32x32x16_bf16(kf, qf[ks], S[kb], 0, 0, 0);
                        if ((ks & 3) == 3) asm volatile("" ::: "memory"); }
                }
                if (64 * j + 63 > q0) {
                    const int qa = q0 + r32;
#pragma unroll
                    for (int kb = 0; kb < 2; ++kb)
#pragma unroll
                        for (int e = 0; e < 16; ++e) { const int ka = 64 * j + 32 * kb + (e & 3) + 8 * (e >> 2) + 4 * hh; if (ka > qa) S[kb][e] = -1.0e30f; }
                }
                float mx = S[0][0];
#pragma unroll
                for (int kb = 0; kb < 2; ++kb)
#pragma unroll
                    for (int e = 0; e < 16; ++e) mx = fmaxf(mx, S[kb][e]);
                mx = fmaxf(mx, __shfl_xor(mx, 32));
                const float m_new = fmaxf(m_run, mx); const float alpha = __builtin_amdgcn_exp2f(m_run - m_new); m_run = m_new;
                float rsum = 0.f;
#pragma unroll
                for (int kb = 0; kb < 2; ++kb)
#pragma unroll
                    for (int e = 0; e < 16; ++e) { const float pv = __builtin_amdgcn_exp2f(S[kb][e] - m_new); S[kb][e] = pv; rsum += pv; }
                rsum += __shfl_xor(rsum, 32);
                l_run = l_run * alpha + rsum;
#pragma unroll
                for (int db = 0; db < 4; ++db)
#pragma unroll
                    for (int e = 0; e < 16; ++e) O[db][e] *= alpha;
                bf16x8 pf[2][2];
#pragma unroll
                for (int kb = 0; kb < 2; ++kb)
#pragma unroll
                    for (int s = 0; s < 2; ++s) { const unsigned a0 = pg8::cvt_pk_bf16(S[kb][8 * s + 0], S[kb][8 * s + 1]), a1 = pg8::cvt_pk_bf16(S[kb][8 * s + 2], S[kb][8 * s + 3]),
                                                                 a2 = pg8::cvt_pk_bf16(S[kb][8 * s + 4], S[kb][8 * s + 5]), a3 = pg8::cvt_pk_bf16(S[kb][8 * s + 6], S[kb][8 * s + 7]);
                        pf[kb][s] = __builtin_bit_cast(bf16x8, (v4u){a0, a1, a2, a3}); }
#pragma unroll
                for (int db = 0; db < 4; ++db)
#pragma unroll
                    for (int kb = 0; kb < 2; ++kb)
#pragma unroll
                        for (int s = 0; s < 2; ++s) { LAS unsigned char* vp = st + AT_VOFF + (32 * db + r32) * AT_VLD + (32 * kb + 16 * s + 4 * hh) * 2;
                            const v2u lo = *(const LAS v2u*)vp, hi = *(const LAS v2u*)(vp + 16);
                            const bf16x8 vf = __builtin_bit_cast(bf16x8, (v4u){lo.x, lo.y, hi.x, hi.y});
                            O[db] = __builtin_amdgcn_mfma_f32_32x32x16_bf16(vf, pf[kb][s], O[db], 0, 0, 0); if (kb == 1 && s == 1) asm volatile("" ::: "memory"); }
            }
            const float inv = 1.0f / l_run;
            GAS unsigned char* o_t = (GAS unsigned char*)(OB + ((size_t)b * 2048 + 256 * qb) * 1024 + h * 128); const unsigned ooff = (unsigned)(32 * w + r32) * 2048u; asm volatile("" : "+s"(o_t));
#pragma unroll
            for (int db = 0; db < 4; ++db)
#pragma unroll
                for (int g4 = 0; g4 < 4; ++g4) { const int d = 32 * db + 8 * g4 + 4 * hh;
                    *(GAS v2u*)(o_t + ooff + 2 * d) = (v2u){pk2(O[db][4 * g4 + 0] * inv, O[db][4 * g4 + 1] * inv), pk2(O[db][4 * g4 + 2] * inv, O[db][4 * g4 + 3] * inv)}; }
#undef AT_LOAD
#undef AT_STORE
        }
    }
    __syncthreads();
}
constexpr size_t WS_S0 = WS_FAST_END;
constexpr size_t WS_XS = WS_S0;
constexpr size_t WS_XSB = WS_XS + 512 * 1024;
constexpr size_t WS_RSTDS = WS_XSB + 256 * 1024;
constexpr size_t WS_SR = WS_RSTDS + 4096;
constexpr size_t WS_SRDQ = WS_SR + 128 * 5632 * 4;
constexpr size_t WS_SRUQ = WS_SRDQ + 128 * 832 * 4;
constexpr size_t WS_SQL = WS_SRUQ + 128 * 1536 * 4;
constexpr size_t WS_DQSS = WS_SQL + 128 * 2048 * 4;
constexpr size_t WS_SG2 = WS_DQSS + 128 * 64 * 4;
constexpr size_t WS_SGU = WS_SG2 + 128 * 2048 * 2;
constexpr size_t WS_SOL = WS_SGU + 128 * 2816 * 2;
constexpr size_t WS_SOB = WS_SOL + 128 * 2048 * 2;
constexpr int NSPLIT = 8;
constexpr size_t WS_PART = WS_SOB + 128 * 1024 * 2;
constexpr size_t WS_PM = WS_PART + (size_t)128 * NSPLIT * 8 * 256 * 4;
constexpr size_t WS_PL = WS_PM + 128 * NSPLIT * 8 * 4;
constexpr size_t WS_S_END = WS_PL + 128 * NSPLIT * 8 * 4;
static_assert(WS_S_END <= WS_NAIVE, "ws map (sample)");

template <bool AF32> struct SgFrag { bf16x8 b; bf16x8 a[8]; };
template <bool AF32>
__device__ __forceinline__ void sg_load(SgFrag<AF32>& f, const void* Ap, size_t arow0, int lda, const bf16* Bt, int kk) {
    f.b = *(const GAS bf16x8*)(Bt + kk);
#pragma unroll
    for (int m = 0; m < 8; ++m) {
        if (AF32) { const float* ap = (const float*)Ap + arow0 + (size_t)(16 * m) * lda + kk; const f32x4 x0 = *(const GAS f32x4*)ap, x1 = *(const GAS f32x4*)(ap + 4);
            f.a[m] = __builtin_bit_cast(bf16x8, (v4u){pk2(x0.x, x0.y), pk2(x0.z, x0.w), pk2(x1.x, x1.y), pk2(x1.z, x1.w)}); }
        else f.a[m] = *(const GAS bf16x8*)((const bf16*)Ap + arow0 + (size_t)(16 * m) * lda + kk); }
}
template <bool AF32, bool OUTBF>
__device__ __forceinline__ void sgemm_phase(Frame& F, const void* Ap, int lda, size_t a_hs, const bf16* Btp, int ldb, size_t b_hs, int nheads, int Nh, int K, int ksplit, float* C, bf16* Cb, int ldc, size_t c_hs, size_t slab, float* ss, int ssld) {
    const int lane = F.lane, w = F.wave, i16 = lane & 15, q = lane >> 4, nks = (K >> 5) / ksplit, uph = Nh >> 4, ncol = nheads * uph;
    LAS float* red = (LAS float*)F.lds;
    for (int u = F.vcu; u < ncol * ksplit; u += F.G) {
        const int uc = u % ncol, sp = u / ncol, h = uc / uph, n0 = 16 * (uc % uph);
        const bf16* Bt = Btp + (size_t)h * b_hs + (size_t)(n0 + i16) * ldb + 8 * q + 32 * sp * nks;
        const size_t arow0 = (size_t)h * a_hs + (size_t)i16 * lda + 8 * q + 32 * sp * nks;
        f32x4 acc[8];
#pragma unroll
        for (int m = 0; m < 8; ++m) acc[m] = (f32x4){0.f, 0.f, 0.f, 0.f};
        SgFrag<AF32> f0, f1;
        if (w < nks) sg_load<AF32>(f0, Ap, arow0, lda, Bt, 32 * w);
        for (int ks = w; ks < nks; ks += 16) {
            if (ks + 8 < nks) sg_load<AF32>(f1, Ap, arow0, lda, Bt, 32 * (ks + 8));
#pragma unroll
            for (int m = 0; m < 8; ++m) acc[m] = __builtin_amdgcn_mfma_f32_16x16x32_bf16(f0.b, f0.a[m], acc[m], 0, 0, 0);
            if (ks + 8 < nks) {
                if (ks + 16 < nks) sg_load<AF32>(f0, Ap, arow0, lda, Bt, 32 * (ks + 16));
#pragma unroll
                for (int m = 0; m < 8; ++m) acc[m] = __builtin_amdgcn_mfma_f32_16x16x32_bf16(f1.b, f1.a[m], acc[m], 0, 0, 0);
            }
        }
        __syncthreads();
#pragma unroll
        for (int m = 0; m < 8; ++m) *(LAS f32x4*)(red + ((w * 128 + 16 * m + i16) * 16 + 4 * q)) = acc[m];
        __syncthreads();
        { const int row = F.tid >> 2, c4 = (F.tid & 3) * 4; f32x4 s = (f32x4){0.f, 0.f, 0.f, 0.f};
#pragma unroll
          for (int w2 = 0; w2 < 8; ++w2) s += *(const LAS f32x4*)(red + ((w2 * 128 + row) * 16 + c4));
          if (OUTBF) *(GAS v2u*)(Cb + (size_t)h * c_hs + (size_t)row * ldc + n0 + c4) = (v2u){pk2(s.x, s.y), pk2(s.z, s.w)};
          else *(GAS f32x4*)(C + (size_t)sp * slab + (size_t)h * c_hs + (size_t)row * ldc + n0 + c4) = s;
          if (ss) { float sq = (s.x * s.x + s.y * s.y) + (s.z * s.z + s.w * s.w); sq += __shfl_xor(sq, 1); sq += __shfl_xor(sq, 2); if ((F.tid & 3) == 0) ss[(size_t)row * ssld + uc] = sq; } }
    }
    __syncthreads();
}
__device__ __forceinline__ float block_sum512(Frame& F, float v, LAS float* red) {
    v = wave_sum(v); __syncthreads(); if (F.lane == 0) red[F.wave] = v; __syncthreads();
    return ((red[0] + red[1]) + (red[2] + red[3])) + ((red[4] + red[5]) + (red[6] + red[7]));
}
__device__ __forceinline__ float gelu_erf_f(float v) { return 0.5f * v * (1.0f + erff(v * 0.70710678118654752f)); }
__device__ __forceinline__ void s_rowA2(Frame& F, const float* SR, const float* RSTDS, const float* sgu_g, const float* w_s, const float* b_s, float* chunkv_out, bf16* SG2) {
    LAS float* ub = (LAS float*)F.lds; LAS float* red = ub + 2048;
    for (int row = F.vcu; row < MS; row += F.G) {
        const float rs = RSTDS[row]; const int c0 = 8 * F.tid; float z[8];
        { const f32x4 a = *(const GAS f32x4*)(SR + (size_t)row * 4096 + c0), b = *(const GAS f32x4*)(SR + (size_t)row * 4096 + c0 + 4);
          z[0] = gelu_erf_f(a.x * rs); z[1] = gelu_erf_f(a.y * rs); z[2] = gelu_erf_f(a.z * rs); z[3] = gelu_erf_f(a.w * rs); z[4] = gelu_erf_f(b.x * rs); z[5] = gelu_erf_f(b.y * rs); z[6] = gelu_erf_f(b.z * rs); z[7] = gelu_erf_f(b.w * rs); }
        float sq = 0.f;
        if (F.tid >= 256) {
#pragma unroll
            for (int e = 0; e < 8; ++e) sq += z[e] * z[e]; }
        else {
#pragma unroll
            for (int e = 0; e < 8; ++e) ub[c0 + e] = z[e]; }
        const float tot = block_sum512(F, sq, red);
        if (F.tid >= 256) { const float rv = rsqrtf(tot * (1.0f / 2048.0f) + EPS); const int cv = c0 - 2048, g = cv >> 8; const float wg = w_s[(size_t)g * 128 * 128], bg = b_s[g * 128]; float o[8];
#pragma unroll
            for (int e = 0; e < 8; ++e) { const float vn = z[e] * rv * sgu_g[cv + e]; chunkv_out[(size_t)row * 2048 + cv + e] = vn; o[e] = ub[cv + e] * (wg * vn + bg); }
            *(GAS v4u*)(SG2 + (size_t)row * 2048 + cv) = (v4u){pk2(o[0], o[1]), pk2(o[2], o[3]), pk2(o[4], o[5]), pk2(o[6], o[7])}; }
        __syncthreads();
    }
}
__device__ __forceinline__ void s_rowpost(Frame& F, const float* SR, int nparts, const float* gain, float* XS, bf16* XSB, float* RSTDS, float* Y) {
    const int gw = F.vcu * NWAVES + F.wave, NGW = F.G * NWAVES;
    for (int m = gw; m < MS; m += NGW) {
        const GAS f32x4* mr = (const GAS f32x4*)(SR + (size_t)m * 1024) + F.lane; const GAS f32x4* gr = (const GAS f32x4*)gain + F.lane; GAS f32x4* xr = (GAS f32x4*)(XS + (size_t)m * 1024) + F.lane;
        f32x4 mv[4]; float ss = 0.f;
#pragma unroll
        for (int j = 0; j < 4; ++j) { mv[j] = mr[64 * j]; for (int p = 1; p < nparts; ++p) mv[j] += mr[(size_t)p * (128 * 1024 / 4) + 64 * j]; ss += (mv[j].x * mv[j].x + mv[j].y * mv[j].y) + (mv[j].z * mv[j].z + mv[j].w * mv[j].w); }
        const float rm = rsqrtf(wave_sum(ss) * (1.0f / 1024.0f) + EPS);
        GAS v2u* xb = (GAS v2u*)(XSB + (size_t)m * 1024) + F.lane; float s = 0.f;
#pragma unroll
        for (int j = 0; j < 4; ++j) { f32x4 x = xr[64 * j]; x = x + mv[j] * rm * gr[64 * j]; xr[64 * j] = x; if (Y) ((GAS f32x4*)(Y + (size_t)m * 1024) + F.lane)[64 * j] = x;
            s += (x.x * x.x + x.y * x.y) + (x.z * x.z + x.w * x.w); xb[64 * j] = (v2u){pk2(x.x, x.y), pk2(x.z, x.w)}; }
        s = wave_sum(s); if (F.lane == 0) RSTDS[m] = rsqrtf(s * (1.0f / 1024.0f) + EPS);
    }
}
__device__ __forceinline__ void s_rowconv(Frame& F, const float* SR, const float* RSTDS, const float* state  , const float* cw, const float* cb, float* conv_out  , bf16* SGUb) {
    for (int row = F.vcu; row < MS; row += F.G) {
        const float rs = RSTDS[row]; const float* s0 = state + (size_t)row * 2 * 5632; const float* s1 = s0 + 5632; const float* a = SR + (size_t)row * 5632; float* o0 = conv_out + (size_t)row * 2 * 5632; float* o1 = o0 + 5632;
        for (int j = F.tid; j < 2816; j += 512) {
            const int jp = (j >> 7) * 256 + (j & 127);
            const float ag = a[jp] * rs, au = a[jp + 128] * rs, p1g = s1[j], p1u = s1[j + 2816];
            o0[j] = p1g; o0[j + 2816] = p1u; o1[j] = ag; o1[j + 2816] = au;
            const float cg = cb[j] + s0[j] * cw[j] + p1g * cw[5632 + j] + ag * cw[2 * 5632 + j];
            const float cu = cb[j + 2816] + s0[j + 2816] * cw[j + 2816] + p1u * cw[5632 + j + 2816] + au * cw[2 * 5632 + j + 2816];
            SGUb[(size_t)row * 2816 + j] = (bf16)f2bf(gelu_tanh_fast(cg) * cu);
        }
    }
}
__device__ __forceinline__ float s_qscale(const float* RSTDS, const float* DQSS, int b) {
    const float rx = RSTDS[b]; float s = 0.f;
#pragma unroll
    for (int k = 0; k < 8; ++k) { const f32x4 v = *(const GAS f32x4*)(DQSS + (size_t)b * 64 + 4 * k); s += (v.x + v.y) + (v.z + v.w); }
    return rx * rsqrtf(rx * rx * s * (1.0f / 512.0f) + EPS);
}
constexpr int SA_LD = 656, SA_TILE = 16 * SA_LD;
__device__ __forceinline__ void sattn_phase(Frame& F, const float* SQL, const float* SRUQ, const float* RSTDS, const float* DQSS, const float* rope, const float* cache_ckv, const float* cache_kr, const int* page_table,
                                            float* PART, float* PM, float* PL) {
    const int lane = F.lane, w = F.wave, i16 = lane & 15, q = lane >> 4;
    LAS unsigned char* tile = F.lds + w * SA_TILE;
    for (int u = F.vcu; u < MS * NSPLIT; u += F.G) {
        const int b = u / NSPLIT, sp = u % NSPLIT;
        const float qs = s_qscale(RSTDS, DQSS, b);
        bf16x8 qf[10];
        if (i16 < 8) {
#pragma unroll
            for (int ks = 0; ks < 8; ++ks) { const float* p = SQL + ((size_t)b * 8 + i16) * 256 + 32 * ks + 8 * q; const f32x4 x0 = *(const GAS f32x4*)p * qs, x1 = *(const GAS f32x4*)(p + 4) * qs;
                qf[ks] = __builtin_bit_cast(bf16x8, (v4u){pk2(x0.x, x0.y), pk2(x0.z, x0.w), pk2(x1.x, x1.y), pk2(x1.z, x1.w)}); }
            const float* pp = SRUQ + (size_t)b * 1536 + i16 * 192 + 128 + 16 * q; float x1[8], x2[8], o1[8], o2[8];
            { const f32x4 a = *(const GAS f32x4*)pp, bb = *(const GAS f32x4*)(pp + 4), c = *(const GAS f32x4*)(pp + 8), d = *(const GAS f32x4*)(pp + 12);
              x1[0] = a.x; x2[0] = a.y; x1[1] = a.z; x2[1] = a.w; x1[2] = bb.x; x2[2] = bb.y; x1[3] = bb.z; x2[3] = bb.w; x1[4] = c.x; x2[4] = c.y; x1[5] = c.z; x2[5] = c.w; x1[6] = d.x; x2[6] = d.y; x1[7] = d.z; x2[7] = d.w; }
#pragma unroll
            for (int e = 0; e < 8; ++e) { const f32x2 cs = *(const GAS f32x2*)(rope + ((size_t)2048 * 32 + 8 * q + e) * 2); o1[e] = (x1[e] * cs.x - x2[e] * cs.y) * qs; o2[e] = (x2[e] * cs.x + x1[e] * cs.y) * qs; }
            qf[8] = __builtin_bit_cast(bf16x8, (v4u){pk2(o1[0], o1[1]), pk2(o1[2], o1[3]), pk2(o1[4], o1[5]), pk2(o1[6], o1[7])});
            qf[9] = __builtin_bit_cast(bf16x8, (v4u){pk2(o2[0], o2[1]), pk2(o2[2], o2[3]), pk2(o2[4], o2[5]), pk2(o2[6], o2[7])});
        } else {
#pragma unroll
            for (int ks = 0; ks < 10; ++ks) qf[ks] = (bf16x8){0, 0, 0, 0, 0, 0, 0, 0};
        }
        f32x4 raw[10][2];
#define SA_LOAD(gi) do { const int key0_ = sp * (PAST_LEN / NSPLIT) + 16 * (gi); const int page_ = page_table[b * NPAGES + (key0_ >> 7)]; const size_t slot_ = (size_t)page_ * PAGE + (key0_ & 127) + i16; \
            const float* cr_ = cache_ckv + slot_ * KV_LORA + 8 * q; const float* kr_ = cache_kr + slot_ * QK_ROPE + 8 * q; \
            _Pragma("unroll") for (int ks = 0; ks < 8; ++ks) { raw[ks][0] = *(const GAS f32x4*)(cr_ + 32 * ks); raw[ks][1] = *(const GAS f32x4*)(cr_ + 32 * ks + 4); } \
            _Pragma("unroll") for (int ks = 0; ks < 2; ++ks) { raw[8 + ks][0] = *(const GAS f32x4*)(kr_ + 32 * ks); raw[8 + ks][1] = *(const GAS f32x4*)(kr_ + 32 * ks + 4); } } while (0)
        SA_LOAD(w);
        float m_run = -1.0e30f, l_run = 0.f;
        f32x4 O[16];
#pragma unroll
        for (int cb = 0; cb < 16; ++cb) O[cb] = (f32x4){0.f, 0.f, 0.f, 0.f};
        __syncthreads();
#pragma unroll 1
        for (int i = 0; i < (PAST_LEN / NSPLIT / 16) / 8; ++i) {
#pragma unroll
            for (int ks = 0; ks < 10; ++ks) { const f32x4 x0 = raw[ks][0], x1 = raw[ks][1];
                *(LAS v4u*)(tile + i16 * SA_LD + (32 * ks + 8 * q) * 2) = (v4u){pk2(x0.x, x0.y), pk2(x0.z, x0.w), pk2(x1.x, x1.y), pk2(x1.z, x1.w)}; }
            if (i + 1 < (PAST_LEN / NSPLIT / 16) / 8) SA_LOAD(w + 8 * (i + 1));
            LDS_WAIT();
            f32x4 sacc = (f32x4){0.f, 0.f, 0.f, 0.f};
#pragma unroll
            for (int ks = 0; ks < 10; ++ks) { const bf16x8 kf = *(const LAS bf16x8*)(tile + i16 * SA_LD + (32 * ks + 8 * q) * 2); sacc = __builtin_amdgcn_mfma_f32_16x16x32_bf16(kf, qf[ks], sacc, 0, 0, 0); }
            float mx = fmaxf(fmaxf(sacc[0], sacc[1]), fmaxf(sacc[2], sacc[3])); mx = fmaxf(mx, __shfl_xor(mx, 16)); mx = fmaxf(mx, __shfl_xor(mx, 32));
            const float m_new = fmaxf(m_run, mx), alpha = __builtin_amdgcn_exp2f(m_run - m_new); m_run = m_new;
            const float p0 = __builtin_amdgcn_exp2f(sacc[0] - m_new), p1 = __builtin_amdgcn_exp2f(sacc[1] - m_new), p2 = __builtin_amdgcn_exp2f(sacc[2] - m_new), p3 = __builtin_amdgcn_exp2f(sacc[3] - m_new);
            float rsum = (p0 + p1) + (p2 + p3); rsum += __shfl_xor(rsum, 16); rsum += __shfl_xor(rsum, 32);
            l_run = l_run * alpha + rsum;
            const bf16x8 pf = __builtin_bit_cast(bf16x8, (v4u){pk2(p0, p1), pk2(p2, p3), 0u, 0u});
#pragma unroll
            for (int cb = 0; cb < 16; ++cb) { const s16x4 t4 = tr_read(tile + (4 * q + (i16 >> 2)) * SA_LD + (16 * cb + 4 * (i16 & 3)) * 2);
                const bf16x8 vf = (bf16x8){t4[0], t4[1], t4[2], t4[3], 0, 0, 0, 0};
                O[cb] = O[cb] * alpha; O[cb] = __builtin_amdgcn_mfma_f32_16x16x32_bf16(vf, pf, O[cb], 0, 0, 0); }
            LDS_WAIT();
        }
#undef SA_LOAD
        __syncthreads();
        { LAS float* Ob = (LAS float*)F.lds; LAS float* mb = (LAS float*)(F.lds + 65536); LAS float* lb = mb + 64;
          if (i16 < 8) {
#pragma unroll
              for (int cb = 0; cb < 16; ++cb) *(LAS f32x4*)(Ob + ((w * 8 + i16) * 256 + 16 * cb + 4 * q)) = O[cb];
              if (q == 0) { mb[w * 8 + i16] = m_run; lb[w * 8 + i16] = l_run; } }
          __syncthreads();
          const int hd = F.tid >> 6, c4 = (F.tid & 63) * 4; float M = mb[hd];
#pragma unroll
          for (int w2 = 1; w2 < 8; ++w2) M = fmaxf(M, mb[w2 * 8 + hd]);
          f32x4 acc = (f32x4){0.f, 0.f, 0.f, 0.f}; float L = 0.f;
#pragma unroll
          for (int w2 = 0; w2 < 8; ++w2) { const float sc = __builtin_amdgcn_exp2f(mb[w2 * 8 + hd] - M); acc += *(const LAS f32x4*)(Ob + ((w2 * 8 + hd) * 256 + c4)) * sc; L += lb[w2 * 8 + hd] * sc; }
          *(GAS f32x4*)(PART + ((size_t)u * 8 + hd) * 256 + c4) = acc;
          if ((F.tid & 63) == 0) { PM[(size_t)u * 8 + hd] = M; PL[(size_t)u * 8 + hd] = L; } }
    }
    __syncthreads();
}
__device__ __forceinline__ void scombine_phase(Frame& F, int first, const float* SRDQ, const float* SQL, const float* SRUQ, const float* RSTDS, const float* DQSS, const float* rope, const float* kv_g,
                                               const float* PART, const float* PM, const float* PL, float* out_ckv, float* out_kr, bf16* SOL) {
    LAS float* ckn = (LAS float*)F.lds; LAS float* krn = ckn + 256; LAS float* red = krn + 64;
    for (int b = F.vcu; b < MS; b += F.G) {
        __syncthreads();
        if (first) {
            const float rx = RSTDS[b]; float v = 0.f, sq = 0.f;
            if (F.tid < 256) { v = SRDQ[(size_t)b * 832 + 512 + F.tid] * rx; sq = v * v; }
            const float tot = block_sum512(F, sq, red);
            if (F.tid < 256) { const float o = v * rsqrtf(tot * (1.0f / 256.0f) + EPS) * kv_g[F.tid]; ckn[F.tid] = o; out_ckv[(size_t)b * 256 + F.tid] = o; }
            else if (F.tid < 288) { const int i = F.tid - 256; const float x1 = SRDQ[(size_t)b * 832 + 768 + i] * rx, x2 = SRDQ[(size_t)b * 832 + 800 + i] * rx; const f32x2 cs = *(const GAS f32x2*)(rope + ((size_t)2048 * 32 + i) * 2);
                const float o1 = x1 * cs.x - x2 * cs.y, o2 = x2 * cs.x + x1 * cs.y; krn[i] = o1; krn[32 + i] = o2; out_kr[(size_t)b * 64 + i] = o1; out_kr[(size_t)b * 64 + 32 + i] = o2; }
        } else {
            if (F.tid < 256) ckn[F.tid] = out_ckv[(size_t)b * 256 + F.tid]; else if (F.tid < 320) krn[F.tid - 256] = out_kr[(size_t)b * 64 + (F.tid - 256)];
        }
        __syncthreads();
        const float qs = s_qscale(RSTDS, DQSS, b);
        const int hd = F.wave, c4 = F.lane * 4;
        const f32x4 ql = *(const GAS f32x4*)(SQL + ((size_t)b * 8 + hd) * 256 + c4); const f32x4 cn = *(const LAS f32x4*)(ckn + c4);
        float dot = (ql.x * cn.x + ql.y * cn.y) + (ql.z * cn.z + ql.w * cn.w);
        if (F.lane < 32) { const float* pp = SRUQ + (size_t)b * 1536 + hd * 192 + 128; const float x1 = pp[2 * F.lane], x2 = pp[2 * F.lane + 1]; const f32x2 cs = *(const GAS f32x2*)(rope + ((size_t)2048 * 32 + F.lane) * 2);
            dot += (x1 * cs.x - x2 * cs.y) * krn[F.lane] + (x2 * cs.x + x1 * cs.y) * krn[32 + F.lane]; }
        const float sn = wave_sum(dot) * qs;
        float M = sn;
#pragma unroll
        for (int sp = 0; sp < NSPLIT; ++sp) M = fmaxf(M, PM[((size_t)b * NSPLIT + sp) * 8 + hd]);
        const float en = __builtin_amdgcn_exp2f(sn - M); float L = en; f32x4 acc = cn * en;
#pragma unroll
        for (int sp = 0; sp < NSPLIT; ++sp) { const size_t pi = ((size_t)b * NSPLIT + sp) * 8 + hd; const float sc = __builtin_amdgcn_exp2f(PM[pi] - M); L += PL[pi] * sc; acc += *(const GAS f32x4*)(PART + pi * 256 + c4) * sc; }
        const float inv = 1.0f / L;
        *(GAS v2u*)(SOL + ((size_t)b * 8 + hd) * 256 + c4) = (v2u){pk2(acc.x * inv, acc.y * inv), pk2(acc.z * inv, acc.w * inv)};
    }
    __syncthreads();
}
__device__ __forceinline__ void s_prologue(Frame& F, const float* x_sample, float* XS, bf16* XSB, float* RSTDS) {
    const int gw = F.vcu * NWAVES + F.wave, NGW = F.G * NWAVES;
    for (int m = gw; m < MS; m += NGW) {
        const GAS f32x4* xr = (const GAS f32x4*)(x_sample + (size_t)m * 1024) + F.lane; GAS f32x4* xo = (GAS f32x4*)(XS + (size_t)m * 1024) + F.lane; GAS v2u* xb = (GAS v2u*)(XSB + (size_t)m * 1024) + F.lane; float s = 0.f;
#pragma unroll
        for (int j = 0; j < 4; ++j) { const f32x4 v = xr[64 * j]; xo[64 * j] = v; s += (v.x * v.x + v.y * v.y) + (v.z * v.z + v.w * v.w); xb[64 * j] = (v2u){pk2(v.x, v.y), pk2(v.z, v.w)}; }
        s = wave_sum(s); if (F.lane == 0) RSTDS[m] = rsqrtf(s * (1.0f / 1024.0f) + EPS);
    }
}
constexpr int NPH_A = 8;
constexpr int NPH_FAST = 1 + 2 * NPH_A + 12 + 12;
#define X ((float*)(ws + WS_X))
#define XB ((bf16*)(ws + WS_XB))
#define RSTD ((float*)(ws + WS_RSTD))
#define U ((bf16*)(ws + WS_U))
#define V ((bf16*)(ws + WS_V))
#define VSS ((float*)(ws + WS_VSS))
#define G2 ((bf16*)(ws + WS_G2))
#define MO ((float*)(ws + WS_MO))
#define MSS ((float*)(ws + WS_MSS))
#define AB ((bf16*)(ws + WS_AB))
#define HALO ((float*)(ws + WS_AB + (size_t)120 * MiB))
#define GU ((bf16*)(ws + WS_GU))
#define CQ ((bf16*)(ws + WS_CQ))
#define CQSS ((float*)(ws + WS_CQSS))
#define KVR ((float*)(ws + WS_KVR))
#define Qb ((bf16*)(ws + WS_Q))
#define CKVB ((bf16*)(ws + WS_CKVB))
#define KRB ((bf16*)(ws + WS_KRB))
#define KN ((bf16*)(ws + WS_KN))
#define VT ((bf16*)(ws + WS_VT))
#define OB ((bf16*)(ws + WS_OB))
#define ROPE ((const float*)(ws + WS_ROPE))
#define y_prompt ((float*)Ap->out)
#define y_sample ((float*)Ap->out + (size_t)MP * D_MODEL)
#define ckv_s (conv_p + (size_t)DEPTH * BATCH * 2 * FF2)
#define kr_s (ckv_s + (size_t)MS * KV_LORA)
#define conv_s (kr_s + (size_t)MS * QK_ROPE)
#define chunkv_s (conv_s + (size_t)DEPTH * MS * 2 * FF2)
#define XS ((float*)(ws + WS_XS))
#define XSB ((bf16*)(ws + WS_XSB))
#define RSTDS ((float*)(ws + WS_RSTDS))
#define SR ((float*)(ws + WS_SR))
#define SRDQ ((float*)(ws + WS_SRDQ))
#define SRUQ ((float*)(ws + WS_SRUQ))
#define SQL ((float*)(ws + WS_SQL))
#define DQSS ((float*)(ws + WS_DQSS))
#define SG2 ((bf16*)(ws + WS_SG2))
#define SGUB ((bf16*)(ws + WS_SGU))
#define SOL ((bf16*)(ws + WS_SOL))
#define SOB ((bf16*)(ws + WS_SOB))
#define PART ((float*)(ws + WS_PART))
#define PMx ((float*)(ws + WS_PM))
#define PLx ((float*)(ws + WS_PL))
#define ckv_p ((float*)Ap->out + (size_t)MP * D_MODEL + (size_t)MS * D_MODEL)
#define kr_p (ckv_p + (size_t)MP * KV_LORA)
#define conv_p (kr_p + (size_t)MP * QK_ROPE)

#ifndef DUPMASK
#define DUPMASK 0
#endif
#define DUP_GEMM(...) for (int r_ = 0; r_ < ((DUPMASK & 1) ? 2 : 1); ++r_) { __VA_ARGS__ }
#define DUP_ATTN(...) for (int r_ = 0; r_ < ((DUPMASK & 2) ? 2 : 1); ++r_) { __VA_ARGS__ }
#define DUP_SATTN(...) for (int r_ = 0; r_ < ((DUPMASK & 4) ? 2 : 1); ++r_) { __VA_ARGS__ }
#define DUP_CONV(...) for (int r_ = 0; r_ < ((DUPMASK & 8) ? 2 : 1); ++r_) { __VA_ARGS__ }
#define DUP_SGU(...) for (int r_ = 0; r_ < ((DUPMASK & 16) ? 2 : 1); ++r_) { __VA_ARGS__ }
#define PHASE_BEGIN if (ph >= lo && ph < hi) { asm volatile("" : "+s"(Ap)); ws = Ap->ws; F.lane = pg8::lane_id_opaque(); F.tid = F.wave * 64 + F.lane;
#define RELANE() do { F.lane = pg8::lane_id_opaque(); F.tid = F.wave * 64 + F.lane; } while (0)
#define PHASE_END if (ph + 1 < hi) { xcd_barrier(bar, F.tid == 0); if (DUPMASK & 32) xcd_barrier(bar, F.tid == 0); } } ++ph;
template <int LAYER> __device__ __forceinline__ void layer_phases(Frame& F, ArgsP& Ap, GAS unsigned char*& ws, const XcdBarrier& bar, int& ph, const int lo, const int hi) {
    constexpr int layer = LAYER;
#define SGEMM(AF, OB_, Ap, lda, ahs, Btp, ldb, bhs, nh, Nh, K, C, Cb, ldc, chs, ss, ssld) for (int r_ = 0; r_ < ((DUPMASK & 128) ? 2 : 1); ++r_) sgemm_phase<AF, OB_>(F, Ap, lda, ahs, Btp, ldb, bhs, nh, Nh, K, 1, C, Cb, ldc, chs, 0, ss, ssld)
#define SGEMM4(Ap, lda, Btp, ldb, K) for (int r_ = 0; r_ < ((DUPMASK & 128) ? 2 : 1); ++r_) sgemm_phase<false, false>(F, Ap, lda, 0, Btp, ldb, 0, 1, 1024, K, 4, SR, nullptr, 1024, 0, (size_t)128 * 1024, nullptr, 0)
    if (layer < 2) {
        PHASE_BEGIN {
            DUP_GEMM({ pg8::Gemm g{XB, (const bf16*)(ws + WS_WIN) + (size_t)layer * 4096 * 1024, MP, 4096, 1024}; pg8::StaticOrder S; S.init(MP, 4096, F.G, (int)blockIdx.x);
              pg8::EpiZ E{U, V, RSTD, VSS};
              pg8::gemm_phase<pg8::EpiZ, pg8::StaticOrder, true, true>(F.lds + RING_OFF, g, S, E, F.wave); })
            RELANE(); SGEMM(false, false, XSB, 1024, 0, (const bf16*)(ws + WS_WIN) + (size_t)layer * 4096 * 1024, 1024, 0, 1, 4096, 1024, SR, nullptr, 4096, 0, nullptr, 0);
        } PHASE_END
        PHASE_BEGIN {
            DUP_SGU(sgu_phase(F, U, V, VSS, ((const float*)Ap->w_s) + (size_t)layer * 8 * 128 * 128, ((const float*)Ap->b_s) + (size_t)layer * 8 * 128, ((const float*)Ap->sgu_g) + (size_t)layer * 2048, G2);)
            RELANE(); s_rowA2(F, SR, RSTDS, ((const float*)Ap->sgu_g) + (size_t)layer * 2048, ((const float*)Ap->w_s) + (size_t)layer * 8 * 128 * 128, ((const float*)Ap->b_s) + (size_t)layer * 8 * 128, chunkv_s + (size_t)layer * MS * 2048, SG2);
        } PHASE_END
        PHASE_BEGIN {
            DUP_GEMM({ pg8::Gemm g{G2, (const bf16*)(ws + WS_WOUT) + (size_t)layer * 1024 * 2048, MP, 1024, 2048}; pg8::StaticOrder S; S.init(MP, 1024, F.G, (int)blockIdx.x);
              pg8::EpiF32SS E{MO, 1024, MSS, 16};
              pg8::gemm_phase<pg8::EpiF32SS, pg8::StaticOrder, true, true>(F.lds + RING_OFF, g, S, E, F.wave); })
            RELANE(); SGEMM4(SG2, 2048, (const bf16*)(ws + WS_WOUT) + (size_t)layer * 1024 * 2048, 2048, 2048);
        } PHASE_END
        PHASE_BEGIN { thin_post(F, MO, MSS, ((const float*)Ap->post_mix_g) + layer * 1024, X, XB, RSTD, nullptr); if (DUPMASK & 64) { thin_post(F, MO, MSS, ((const float*)Ap->post_mix_g) + layer * 1024, (float*)(ws + WS_AB), (bf16*)(ws + WS_AB + (size_t)64 * MiB), (float*)(ws + WS_AB + (size_t)100 * MiB), nullptr); } RELANE(); s_rowpost(F, SR, 4, ((const float*)Ap->post_mix_g) + layer * 1024, XS, XSB, RSTDS, nullptr); } PHASE_END
    } else {
        constexpr int j = layer - 2;
        PHASE_BEGIN {
            DUP_GEMM({ pg8::Gemm g{XB, (const bf16*)(ws + (j ? WS_WDQ1 : WS_WDQ0)), MP, j ? 512 : 1024, 1024}; pg8::StaticOrder S; S.init(MP, j ? 512 : 1024, F.G, (int)blockIdx.x);
              pg8::EpiDq E{CQ, RSTD, CQSS, KVR};
              pg8::gemm_phase<pg8::EpiDq, pg8::StaticOrder, true, true>(F.lds + RING_OFF, g, S, E, F.wave); })
            RELANE(); SGEMM(false, false, XSB, 1024, 0, (const bf16*)(ws + (j ? WS_WDQ1 : WS_WDQ0)), 1024, 0, 1, j ? 512 : 832, 1024, SRDQ, nullptr, 832, 0, DQSS, 64);
        } PHASE_END
        PHASE_BEGIN {
            if (j == 0) kvfinal_phase(F, KVR, ((const float*)Ap->kv_g), ROPE, ckv_p, kr_p, CKVB, KRB);
            DUP_GEMM({ pg8::Gemm g{CQ, (const bf16*)(ws + WS_WUQ) + (size_t)j * 1536 * 512, MP, 1536, 512}; pg8::StaticOrder S; S.init(MP, 1536, F.G, (int)blockIdx.x);
              pg8::EpiQ E{Qb, CQSS, ROPE};
              pg8::gemm_phase<pg8::EpiQ, pg8::StaticOrder, true, true>(F.lds + RING_OFF, g, S, E, F.wave); })
            RELANE(); SGEMM(true, false, SRDQ, 832, 0, (const bf16*)(ws + WS_WUQ) + (size_t)j * 1536 * 512, 512, 0, 1, 1536, 512, SRUQ, nullptr, 1536, 0, nullptr, 0);
        } PHASE_END
        PHASE_BEGIN {
            if (j == 0) {
                DUP_GEMM({ pg8::Gemm g{CKVB, (const bf16*)(ws + WS_WKV), MP, 1024, 256}; pg8::StaticOrder S; S.init(MP, 1024, F.G, (int)blockIdx.x); pg8::EpiBf E{KN, 1024};
                  pg8::gemm_phase<pg8::EpiBf, pg8::StaticOrder, true, true>(F.lds + RING_OFF, g, S, E, F.wave); })
                DUP_GEMM({ pg8::Gemm g{(const bf16*)(ws + WS_WKV) + (size_t)1024 * 256, CKVB, 1024, MP, 256}; pg8::StaticOrder S; S.init(1024, MP, F.G, (int)blockIdx.x); pg8::EpiBf E{VT, MP};
                  pg8::gemm_phase<pg8::EpiBf, pg8::StaticOrder, true, true>(F.lds + RING_OFF, g, S, E, F.wave); })
            }
            RELANE(); SGEMM(true, false, SRUQ, 1536, 192, (const bf16*)(ws + WS_WUKN), 1024, 128, 8, 256, 128, SQL, nullptr, 2048, 256, nullptr, 0);
        } PHASE_END
        PHASE_BEGIN {
            for (int it_ = 0; it_ < 2; ++it_) {
                const bool prompt_part = ((it_ == 0) != ((F.vcu & 1) != 0));
                if (prompt_part) { DUP_ATTN(RELANE(); attn_phase(F, Qb, KN, KRB, VT, OB);) }
                else { DUP_SATTN(RELANE(); sattn_phase(F, SQL, SRUQ, RSTDS, DQSS, ROPE, ((const float*)Ap->cache_ckv), ((const float*)Ap->cache_kr), ((const int*)Ap->page_table), PART, PMx, PLx);) }
            }
        } PHASE_END
        PHASE_BEGIN {
            DUP_GEMM({ pg8::Gemm g{OB, (const bf16*)(ws + WS_WO) + (size_t)j * 1024 * 1024, MP, 1024, 1024}; pg8::StaticOrder S; S.init(MP, 1024, F.G, (int)blockIdx.x);
              pg8::EpiF32SS E{MO, 1024, MSS, 16};
              pg8::gemm_phase<pg8::EpiF32SS, pg8::StaticOrder, true, true>(F.lds + RING_OFF, g, S, E, F.wave); })
            RELANE(); scombine_phase(F, j == 0, SRDQ, SQL, SRUQ, RSTDS, DQSS, ROPE, ((const float*)Ap->kv_g), PART, PMx, PLx, ckv_s, kr_s, SOL);
        } PHASE_END
        PHASE_BEGIN {
            thin_post(F, MO, MSS, ((const float*)Ap->post_mix_g) + layer * 1024, X, XB, RSTD, nullptr); if (DUPMASK & 64) { thin_post(F, MO, MSS, ((const float*)Ap->post_mix_g) + layer * 1024, (float*)(ws + WS_AB), (bf16*)(ws + WS_AB + (size_t)64 * MiB), (float*)(ws + WS_AB + (size_t)100 * MiB), nullptr); }
            RELANE(); SGEMM(false, true, SOL, 2048, 256, (const bf16*)(ws + WS_WKV) + (size_t)1024 * 256, 256, (size_t)128 * 256, 8, 128, 256, nullptr, SOB, 1024, 128, nullptr, 0);
        } PHASE_END
    }
    PHASE_BEGIN {
        DUP_GEMM({ pg8::Gemm g{XB, (const bf16*)(ws + WS_WUP) + (size_t)layer * 5632 * 1024, MP, 5632, 1024}; pg8::StaticOrder S; S.init(MP, 5632, F.G, (int)blockIdx.x);
          pg8::EpiUpConv E{GU, RSTD, ((const float*)Ap->conv_w) + (size_t)layer * 3 * 5632, ((const float*)Ap->conv_b) + (size_t)layer * 5632, conv_p + (size_t)layer * 8 * 2 * 5632, HALO, F.lds + XL_OFF};
          pg8::gemm_phase<pg8::EpiUpConv, pg8::StaticOrder, true, true>(F.lds + RING_OFF, g, S, E, F.wave); })
        RELANE(); if (layer < 2) SGEMM(false, false, XSB, 1024, 0, (const bf16*)(ws + WS_WUP) + (size_t)layer * 5632 * 1024, 1024, 0, 1, 5632, 1024, SR, nullptr, 5632, 0, nullptr, 0);
        else SGEMM4(SOB, 1024, (const bf16*)(ws + WS_WO) + (size_t)(layer - 2) * 1024 * 1024, 1024, 1024);
    } PHASE_END
    PHASE_BEGIN {
        RELANE(); if (layer < 2) s_rowconv(F, SR, RSTDS, ((const float*)Ap->state_conv) + (size_t)layer * MS * 2 * 5632, ((const float*)Ap->conv_w) + (size_t)layer * 3 * 5632, ((const float*)Ap->conv_b) + (size_t)layer * 5632, conv_s + (size_t)layer * MS * 2 * 5632, SGUB);
        else s_rowpost(F, SR, 4, ((const float*)Ap->post_mix_g) + layer * 1024, XS, XSB, RSTDS, nullptr);
    } PHASE_END
    PHASE_BEGIN {
        { pg8::StaticOrder S; S.init(MP, 1024, F.G, (int)blockIdx.x); pg8::Unit pu; for (int i = 0; S.next(i, pu); ++i) conv_patch_panel(F, pu.pm, HALO, ((const float*)Ap->conv_w) + (size_t)layer * 3 * 5632, ((const float*)Ap->conv_b) + (size_t)layer * 5632, GU); VM_WAIT(); __syncthreads(); }
        DUP_GEMM({ pg8::Gemm g{GU, (const bf16*)(ws + WS_WDN) + (size_t)layer * 1024 * 2816, MP, 1024, 2816}; pg8::StaticOrder S; S.init(MP, 1024, F.G, (int)blockIdx.x);
          pg8::EpiF32SS E{MO, 1024, MSS, 16};
          pg8::gemm_phase<pg8::EpiF32SS, pg8::StaticOrder, true, true>(F.lds + RING_OFF, g, S, E, F.wave); })
        RELANE(); if (layer < 2) SGEMM4(SGUB, 2816, (const bf16*)(ws + WS_WDN) + (size_t)layer * 1024 * 2816, 2816, 2816);
        else SGEMM(false, false, XSB, 1024, 0, (const bf16*)(ws + WS_WUP) + (size_t)layer * 5632 * 1024, 1024, 0, 1, 5632, 1024, SR, nullptr, 5632, 0, nullptr, 0);
    } PHASE_END
    PHASE_BEGIN {
        thin_post(F, MO, MSS, ((const float*)Ap->post_ffn_g) + layer * 1024, X, XB, RSTD, layer == 3 ? y_prompt : nullptr); if (DUPMASK & 64) { thin_post(F, MO, MSS, ((const float*)Ap->post_ffn_g) + layer * 1024, (float*)(ws + WS_AB), (bf16*)(ws + WS_AB + (size_t)64 * MiB), (float*)(ws + WS_AB + (size_t)100 * MiB), nullptr); }
        RELANE(); if (layer < 2) s_rowpost(F, SR, 4, ((const float*)Ap->post_ffn_g) + layer * 1024, XS, XSB, RSTDS, nullptr);
        else s_rowconv(F, SR, RSTDS, ((const float*)Ap->state_conv) + (size_t)layer * MS * 2 * 5632, ((const float*)Ap->conv_w) + (size_t)layer * 3 * 5632, ((const float*)Ap->conv_b) + (size_t)layer * 5632, conv_s + (size_t)layer * MS * 2 * 5632, SGUB);
    } PHASE_END
    if (layer >= 2) {
        PHASE_BEGIN { SGEMM4(SGUB, 2816, (const bf16*)(ws + WS_WDN) + (size_t)layer * 1024 * 2816, 2816, 2816); } PHASE_END
        PHASE_BEGIN { s_rowpost(F, SR, 4, ((const float*)Ap->post_ffn_g) + layer * 1024, XS, XSB, RSTDS, layer == 3 ? y_sample : nullptr); } PHASE_END
    }
#undef SGEMM
#undef SGEMM4
}
__global__ void __launch_bounds__(NWAVES * 64, 2) fwd(Args A_) {
    extern __shared__ __attribute__((aligned(16))) unsigned char lds_raw[];
    Frame F;
    F.lds = (LAS unsigned char*)lds_raw;
    F.MISC = (volatile LAS unsigned*)(F.lds + MISC_OFF);
    F.tid = threadIdx.x; F.lane = F.tid & 63; F.wave = __builtin_amdgcn_readfirstlane(F.tid >> 6);
    F.G = gridDim.x; { const int bx = blockIdx.x; F.vcu = (F.G % 8 == 0) ? (bx % 8) * (F.G / 8) + bx / 8 : bx; }
    ArgsP Ap = (ArgsP)__builtin_amdgcn_kernarg_segment_ptr();
    GAS unsigned char* ws = Ap->ws;
    F.ctl = (gu32*)(ws + WS_CTL);
    for (int u = F.tid; u < (LDS_BYTES - LDSCTL_OFF) / 4; u += NWAVES * 64) ((LAS unsigned*)(F.lds + LDSCTL_OFF))[u] = 0u;
    __syncthreads();
    XcdBarrier bar = xcd_barrier_post((unsigned*)(F.ctl + CW_BAR), F.MISC + 8, F.tid == 0);
    const int lo = Ap->ph_lo, hi = Ap->ph_hi; int ph = 0;
    PHASE_BEGIN { for (int r_ = 0; r_ < ((DUPMASK & 256) ? 2 : 1); ++r_) p0_prologue(F, Ap); RELANE(); s_prologue(F, ((const float*)Ap->x_sample), XS, XSB, RSTDS); } PHASE_END
    layer_phases<0>(F, Ap, ws, bar, ph, lo, hi);
    layer_phases<1>(F, Ap, ws, bar, ph, lo, hi);
    layer_phases<2>(F, Ap, ws, bar, ph, lo, hi);
    layer_phases<3>(F, Ap, ws, bar, ph, lo, hi);
}
#undef PHASE_BEGIN
#undef PHASE_END
#undef X
#undef XB
#undef RSTD
#undef U
#undef V
#undef VSS
#undef G2
#undef MO
#undef MSS
#undef AB
#undef HALO
#undef GU
#undef CQ
#undef CQSS
#undef KVR
#undef Qb
#undef CKVB
#undef KRB
#undef KN
#undef VT
#undef OB
#undef ROPE
#undef y_prompt
#undef y_sample
#undef ckv_s
#undef kr_s
#undef conv_s
#undef chunkv_s
#undef XS
#undef XSB
#undef RSTDS
#undef SR
#undef SRDQ
#undef SRUQ
#undef SQL
#undef DQSS
#undef SG2
#undef SGUB
#undef SOL
#undef SOB
#undef PART
#undef PMx
#undef PLx
#undef ckv_p
#undef kr_p
#undef conv_p

struct Ptrs {
    const float *x_prompt, *x_sample, *cache_ckv, *cache_kr, *state_conv; const int* page_table;
    const float *pre_mix_g, *post_mix_g, *pre_ffn_g, *post_ffn_g, *w_in_a, *sgu_g, *w_s, *b_s, *w_out_a, *kv_in_g, *w_dkv, *kv_g, *w_uk, *w_uv, *w_dq, *q_g, *w_uq, *w_o, *w_up, *conv_w, *conv_b, *w_down;
};
static void gemm(hipStream_t st, bool tb, const float* A, int lda, const float* B, int ldb, float* C, int ldc, int M, int N, int K, int accum = 0) {
    dim3 grid(N / 64, M / 64);
    if (tb) hipLaunchKernelGGL(nk_gemm<true>, grid, dim3(256), 0, st, A, lda, B, ldb, C, ldc, M, N, K, accum);
    else hipLaunchKernelGGL(nk_gemm<false>, grid, dim3(256), 0, st, A, lda, B, ldb, C, ldc, M, N, K, accum);
}
struct Bufs { float *X, *H, *Z, *G2, *MO, *A, *GU, *KV, *CKV, *KR, *CQ, *Q, *QL, *QP, *OL, *O, *S, *Ss; };

static void run_group_naive(hipStream_t st, const Ptrs& P, Bufs W, const float* xin, int nb, int T, int pos0, bool sample, int first_layer,
                            float* y, float* out_ckv, float* out_kr, float* out_conv, float* out_chunkv) {
    const int M = nb * T;
    W.CKV = out_ckv; W.KR = out_kr;
    if (first_layer == 0) (void)hipMemcpyAsync(W.X, xin, (size_t)M * D_MODEL * 4, hipMemcpyDeviceToDevice, st);
    const float scale = 1.0f / sqrtf((float)(QK_NOPE + QK_ROPE));
    for (int layer = first_layer; layer < DEPTH; ++layer) {
        if (layer == N_A) {
            hipLaunchKernelGGL(nk_rmsnorm, dim3(M), dim3(256), 0, st, W.X, D_MODEL, P.kv_in_g, W.H, D_MODEL, D_MODEL);
            gemm(st, false, W.H, D_MODEL, P.w_dkv, 320, W.KV, 320, M, 320, D_MODEL);
            hipLaunchKernelGGL(nk_rmsnorm, dim3(M), dim3(256), 0, st, W.KV, 320, P.kv_g, W.CKV, KV_LORA, KV_LORA);
            hipLaunchKernelGGL(nk_rope, dim3(1024), dim3(256), 0, st, W.KV, 320, 256, 0, 1, W.KR, 64, 0, 0, M, T, pos0);
        }
        hipLaunchKernelGGL(nk_rmsnorm, dim3(M), dim3(256), 0, st, W.X, D_MODEL, P.pre_mix_g + layer * D_MODEL, W.H, D_MODEL, D_MODEL);
        if (layer < N_A) {
            gemm(st, false, W.H, D_MODEL, P.w_in_a + (size_t)layer * D_MODEL * 4096, 4096, W.Z, 4096, M, 4096, D_MODEL);
            hipLaunchKernelGGL(nk_gelu_exact, dim3(2048), dim3(256), 0, st, W.Z, (size_t)M * 4096);
            hipLaunchKernelGGL(nk_rmsnorm, dim3(M), dim3(256), 0, st, W.Z + 2048, 4096, P.sgu_g + layer * 2048, W.Z + 2048, 4096, 2048);
            if (sample) hipLaunchKernelGGL(nk_copy2d, dim3(256), dim3(256), 0, st, W.Z + 2048, 4096, out_chunkv + (size_t)layer * M * 2048, 2048, M, 2048);
            const int cl = T >= CHUNK ? CHUNK : T;
            hipLaunchKernelGGL(nk_sgu, dim3(M / cl, 8), dim3(256), 0, st, W.Z, P.w_s + (size_t)layer * 8 * CHUNK * CHUNK, P.b_s + (size_t)layer * 8 * CHUNK, W.G2, cl);
            gemm(st, false, W.G2, 2048, P.w_out_a + (size_t)layer * 2048 * D_MODEL, D_MODEL, W.MO, D_MODEL, M, D_MODEL, 2048);
        } else {
            const int j = layer - N_A;
            gemm(st, false, W.H, D_MODEL, P.w_dq + (size_t)j * D_MODEL * Q_LORA, Q_LORA, W.Q  , Q_LORA, M, Q_LORA, D_MODEL);
            hipLaunchKernelGGL(nk_rmsnorm, dim3(M), dim3(256), 0, st, W.Q, Q_LORA, P.q_g + j * Q_LORA, W.CQ, Q_LORA, Q_LORA);
            gemm(st, false, W.CQ, Q_LORA, P.w_uq + (size_t)j * Q_LORA * 1536, 1536, W.Q, 1536, M, 1536, Q_LORA);
            hipLaunchKernelGGL(nk_rope, dim3(1024), dim3(256), 0, st, W.Q, 1536, 128, 192, 8, W.QP, 512, 0, 64, M, T, pos0);
            for (int h = 0; h < NH; ++h) gemm(st, true, W.Q + h * 192, 1536, P.w_uk + h * 128, 1024, W.QL + h * 256, 2048, M, 256, 128);
            if (!sample) {
                for (int b = 0; b < nb; ++b) for (int h = 0; h < NH; ++h) {
                    gemm(st, true, W.QL + (size_t)b * T * 2048 + h * 256, 2048, W.CKV + (size_t)b * T * 256, 256, W.S, T, T, T, 256, 0);
                    gemm(st, true, W.QP + (size_t)b * T * 512 + h * 64, 512, W.KR + (size_t)b * T * 64, 64, W.S, T, T, T, 64, 1);
                    hipLaunchKernelGGL(nk_softmax_causal, dim3(T), dim3(256), 0, st, W.S, T, scale);
                    gemm(st, false, W.S, T, W.CKV + (size_t)b * T * 256, 256, W.OL + (size_t)b * T * 2048 + h * 256, 2048, T, 256, T, 0);
                }
            } else {
                hipLaunchKernelGGL(nk_sattn_scores, dim3(MS), dim3(256), 0, st, W.QL, W.QP, P.cache_ckv, P.cache_kr, P.page_table, W.CKV, W.KR, W.Ss, scale);
                hipLaunchKernelGGL(nk_sattn_softmax, dim3(MS * 8), dim3(256), 0, st, W.Ss);
                hipLaunchKernelGGL(nk_sattn_pv, dim3(MS), dim3(256), 0, st, W.Ss, P.cache_ckv, P.page_table, W.CKV, W.OL);
            }
            for (int h = 0; h < NH; ++h) gemm(st, false, W.OL + h * 256, 2048, P.w_uv + h * 128, 1024, W.O + h * 128, 1024, M, 128, 256);
            gemm(st, false, W.O, 1024, P.w_o + (size_t)j * 1024 * 1024, 1024, W.MO, 1024, M, 1024, 1024);
        }
        hipLaunchKernelGGL(nk_resid_rmsnorm, dim3(M), dim3(256), 0, st, W.X, W.MO, P.post_mix_g + layer * D_MODEL, D_MODEL);
        hipLaunchKernelGGL(nk_rmsnorm, dim3(M), dim3(256), 0, st, W.X, D_MODEL, P.pre_ffn_g + layer * D_MODEL, W.H, D_MODEL, D_MODEL);
        gemm(st, false, W.H, D_MODEL, P.w_up + (size_t)layer * D_MODEL * FF2, FF2, W.A, FF2, M, FF2, D_MODEL);
        hipLaunchKernelGGL(nk_conv_gate, dim3(4096), dim3(256), 0, st, W.A, sample ? P.state_conv + (size_t)layer * nb * 2 * FF2 : (const float*)nullptr,
                           P.conv_w + (size_t)layer * 3 * FF2, P.conv_b + (size_t)layer * FF2, W.GU, out_conv + (size_t)layer * nb * 2 * FF2, nb, T);
        gemm(st, false, W.GU, D_FF, P.w_down + (size_t)layer * D_FF * D_MODEL, D_MODEL, W.MO, D_MODEL, M, D_MODEL, D_FF);
        hipLaunchKernelGGL(nk_resid_rmsnorm, dim3(M), dim3(256), 0, st, W.X, W.MO, P.post_ffn_g + layer * D_MODEL, D_MODEL);
    }
    (void)hipMemcpyAsync(y, W.X, (size_t)M * D_MODEL * 4, hipMemcpyDeviceToDevice, st);
}

extern "C" void kernel_launch(void* const* d_in, const int* in_sizes, int n_in, void* d_out, int out_size, void* d_ws, size_t ws_size, hipStream_t stream) {
    Ptrs P;
    P.x_prompt = (const float*)d_in[0]; P.x_sample = (const float*)d_in[1]; P.cache_ckv = (const float*)d_in[2]; P.cache_kr = (const float*)d_in[3]; P.state_conv = (const float*)d_in[4];
    P.page_table = (const int*)d_in[5]; P.pre_mix_g = (const float*)d_in[6]; P.post_mix_g = (const float*)d_in[7]; P.pre_ffn_g = (const float*)d_in[8]; P.post_ffn_g = (const float*)d_in[9];
    P.w_in_a = (const float*)d_in[10]; P.sgu_g = (const float*)d_in[11]; P.w_s = (const float*)d_in[12]; P.b_s = (const float*)d_in[13]; P.w_out_a = (const float*)d_in[14];
    P.kv_in_g = (const float*)d_in[15]; P.w_dkv = (const float*)d_in[16]; P.kv_g = (const float*)d_in[17]; P.w_uk = (const float*)d_in[18]; P.w_uv = (const float*)d_in[19];
    P.w_dq = (const float*)d_in[20]; P.q_g = (const float*)d_in[21]; P.w_uq = (const float*)d_in[22]; P.w_o = (const float*)d_in[23]; P.w_up = (const float*)d_in[24];
    P.conv_w = (const float*)d_in[25]; P.conv_b = (const float*)d_in[26]; P.w_down = (const float*)d_in[27];

    float* out = (float*)d_out;
    float* y_prompt = out; float* y_sample = y_prompt + (size_t)MP * D_MODEL; float* ckv_p = y_sample + (size_t)MS * D_MODEL; float* kr_p = ckv_p + (size_t)MP * KV_LORA;
    float* conv_p = kr_p + (size_t)MP * QK_ROPE; float* ckv_s = conv_p + (size_t)DEPTH * BATCH * 2 * FF2; float* kr_s = ckv_s + (size_t)MS * KV_LORA;
    float* conv_s = kr_s + (size_t)MS * QK_ROPE; float* chunkv_s = conv_s + (size_t)DEPTH * MS * 2 * FF2;

    static int grid = 0;
    if (grid == 0) {
        int dev = 0, cus = 0;
        if (hipGetDevice(&dev) != hipSuccess || hipDeviceGetAttribute(&cus, hipDeviceAttributeMultiprocessorCount, dev) != hipSuccess) { fprintf(stderr, "kernel_launch: device query failed\n"); grid = -1; return; }
        if (hipFuncSetAttribute((const void*)fwd, hipFuncAttributeMaxDynamicSharedMemorySize, LDS_BYTES) != hipSuccess) { fprintf(stderr, "kernel_launch: hipFuncSetAttribute failed\n"); grid = -1; return; }
        (void)hipGetLastError();
        grid = cus;
    }
    if (grid < 0) return;

    float* w = (float*)((unsigned char*)d_ws + WS_NAIVE); size_t off = 0;
    auto take = [&](size_t n) { float* p = w + off; off += (n + 63) & ~(size_t)63; return p; };
    Bufs W;
    W.X = take((size_t)MP * 1024); W.H = take((size_t)MP * 1024); W.Z = take((size_t)MP * 4096); W.G2 = take((size_t)MP * 2048); W.MO = take((size_t)MP * 1024);
    W.A = take((size_t)MP * FF2); W.GU = take((size_t)MP * D_FF); W.KV = take((size_t)MP * 320); W.CKV = nullptr; W.KR = nullptr;
    W.CQ = take((size_t)MP * 512); W.Q = take((size_t)MP * 1536); W.QL = take((size_t)MP * 2048); W.QP = take((size_t)MP * 512); W.OL = take((size_t)MP * 2048);
    W.O = take((size_t)MP * 1024); W.S = take((size_t)SEQ * SEQ); W.Ss = take((size_t)MS * 8 * SLD);
    if (WS_NAIVE + off * 4 > ws_size) { fprintf(stderr, "workspace too small: need %zu have %zu\n", WS_NAIVE + off * 4, ws_size); return; }

    (void)hipMemsetAsync((char*)d_ws + WS_CTL, 0, CTL_ZERO_BYTES, stream);
    Args a{};
    a.x_prompt = (decltype(a.x_prompt))P.x_prompt; a.x_sample = (decltype(a.x_sample))P.x_sample; a.cache_ckv = (decltype(a.cache_ckv))P.cache_ckv; a.cache_kr = (decltype(a.cache_kr))P.cache_kr; a.state_conv = (decltype(a.state_conv))P.state_conv; a.page_table = (decltype(a.page_table))P.page_table;
    a.pre_mix_g = (decltype(a.pre_mix_g))P.pre_mix_g; a.post_mix_g = (decltype(a.post_mix_g))P.post_mix_g; a.pre_ffn_g = (decltype(a.pre_ffn_g))P.pre_ffn_g; a.post_ffn_g = (decltype(a.post_ffn_g))P.post_ffn_g; a.w_in_a = (decltype(a.w_in_a))P.w_in_a; a.sgu_g = (decltype(a.sgu_g))P.sgu_g; a.w_s = (decltype(a.w_s))P.w_s; a.b_s = (decltype(a.b_s))P.b_s;
    a.w_out_a = (decltype(a.w_out_a))P.w_out_a; a.kv_in_g = (decltype(a.kv_in_g))P.kv_in_g; a.w_dkv = (decltype(a.w_dkv))P.w_dkv; a.kv_g = (decltype(a.kv_g))P.kv_g; a.w_uk = (decltype(a.w_uk))P.w_uk; a.w_uv = (decltype(a.w_uv))P.w_uv; a.w_dq = (decltype(a.w_dq))P.w_dq; a.q_g = (decltype(a.q_g))P.q_g; a.w_uq = (decltype(a.w_uq))P.w_uq; a.w_o = (decltype(a.w_o))P.w_o;
    a.w_up = (decltype(a.w_up))P.w_up; a.conv_w = (decltype(a.conv_w))P.conv_w; a.conv_b = (decltype(a.conv_b))P.conv_b; a.w_down = (decltype(a.w_down))P.w_down; a.out = (GAS float*)out; a.ws = (GAS unsigned char*)d_ws;
#ifndef MK_PER_PHASE
    a.ph_lo = 0; a.ph_hi = NPH_FAST; hipLaunchKernelGGL(fwd, dim3(grid), dim3(NWAVES * 64), LDS_BYTES, stream, a);
#else
    for (int ph = 0; ph < NPH_FAST; ++ph) { a.ph_lo = ph; a.ph_hi = ph + 1; hipLaunchKernelGGL(fwd, dim3(grid), dim3(NWAVES * 64), LDS_BYTES, stream, a); }
#endif
    { const hipError_t le = hipPeekAtLastError(); if (le != hipSuccess) fprintf(stderr, "kernel_launch: launch failed: %s\n", hipGetErrorName(le)); }

}
```
